# Optimizing an MI355X kernel written in HIP

```python
import math
import jax, jax.numpy as jnp
from jax import lax
import numpy as np

D_MODEL = 1024
BATCH = 4
SEQ = 8192
DEPTH = 1

HEAD_DIM = 64
SWA_Q_HEADS = 8
SWA_KV_HEADS = 2
SWA_GROUP = SWA_Q_HEADS // SWA_KV_HEADS
WINDOW = 128
DIFF_HEADS = 4
DIFF_V_DIM = 2 * HEAD_DIM
SWA_WIDTH = SWA_Q_HEADS * HEAD_DIM
DIFF_WIDTH = DIFF_HEADS * DIFF_V_DIM
MIX_WIDTH = SWA_WIDTH + DIFF_WIDTH
QA_COLS = SWA_Q_HEADS * HEAD_DIM
KA_COLS = SWA_KV_HEADS * HEAD_DIM
VA_COLS = SWA_KV_HEADS * HEAD_DIM
QB_COLS = DIFF_HEADS * 2 * HEAD_DIM
KB_COLS = DIFF_HEADS * 2 * HEAD_DIM
VB_COLS = DIFF_HEADS * DIFF_V_DIM
IN_COLS = QA_COLS + KA_COLS + VA_COLS + QB_COLS + KB_COLS + VB_COLS
IN_SPLITS = (QA_COLS, QA_COLS + KA_COLS, QA_COLS + KA_COLS + VA_COLS,
             QA_COLS + KA_COLS + VA_COLS + QB_COLS,
             QA_COLS + KA_COLS + VA_COLS + QB_COLS + KB_COLS)
Q_BLOCK = 128
D_FF = 4 * D_MODEL
CONV_WIDTH = 3
EPS = 1e-6

kernel_name = "hymba_swa_sink_diffattn_alibi_convffn"


def rms_norm(x, g):
    xf = x.astype(jnp.float32)
    xf = xf * lax.rsqrt(jnp.mean(xf * xf, axis=-1, keepdims=True) + EPS)
    return (xf * g.astype(jnp.float32)).astype(x.dtype)


def alibi_slopes(n):
    def pow2(m):
        start = 2.0 ** (-8.0 / m)
        return [start ** (i + 1) for i in range(m)]
    if math.log2(n).is_integer():
        s = pow2(n)
    else:
        c = 2 ** int(math.floor(math.log2(n)))
        s = pow2(c) + pow2(2 * c)[0::2][: n - c]
    return np.array(sorted(s, reverse=True), dtype=np.float32)


def swa_sink_attention(q, k, v, sinks, slopes):
    B, S = q.shape[0], q.shape[1]
    nb = S // WINDOW
    qb = q.reshape(B, nb, WINDOW, SWA_KV_HEADS, SWA_GROUP, HEAD_DIM)
    kb = k.reshape(B, nb, WINDOW, SWA_KV_HEADS, HEAD_DIM)
    vb = v.reshape(B, nb, WINDOW, SWA_KV_HEADS, HEAD_DIM)
    pad = ((0, 0), (1, 0), (0, 0), (0, 0), (0, 0))
    kk = jnp.concatenate([jnp.pad(kb, pad)[:, :-1], kb], axis=2)
    vv = jnp.concatenate([jnp.pad(vb, pad)[:, :-1], vb], axis=2)
    scores = jnp.einsum("bnqhgd,bnkhd->bnhgqk", qb, kk).astype(jnp.float32)
    scores = scores * (HEAD_DIM ** -0.5)
    qpos = jnp.arange(WINDOW)[:, None] + WINDOW
    kpos = jnp.arange(2 * WINDOW)[None, :]
    dist = qpos - kpos
    valid = (dist >= 0) & (dist < WINDOW)
    abs_k = jnp.arange(nb)[:, None, None] * WINDOW + kpos[None] - WINDOW
    valid = valid[None] & (abs_k >= 0)
    sl = slopes.reshape(SWA_KV_HEADS, SWA_GROUP)[:, :, None, None]
    scores = scores - sl * dist.astype(jnp.float32)[None, None]
    scores = jnp.where(valid[None, :, None, None], scores, -jnp.inf)
    sink = jnp.broadcast_to(
        sinks.astype(jnp.float32).reshape(1, 1, SWA_KV_HEADS, SWA_GROUP, 1, 1),
        scores.shape[:-1] + (1,))
    p = jax.nn.softmax(jnp.concatenate([scores, sink], axis=-1), axis=-1)[..., :-1]
    out = jnp.einsum("bnhgqk,bnkhd->bnqhgd", p.astype(v.dtype), vv)
    return out.reshape(B, S, SWA_Q_HEADS * HEAD_DIM)


def diff_attention(q, k, v, lam, slopes, subln_g, lambda_init):
    B, S = q.shape[0], q.shape[1]
    nb = S // Q_BLOCK
    qb = q.reshape(B, nb, Q_BLOCK, DIFF_HEADS, 2, HEAD_DIM).transpose(1, 0, 2, 3, 4, 5)
    kpos = jnp.arange(S)

    def block(args):
        q_blk, i = args
        s = jnp.einsum("bqhmd,bkhmd->bhmqk", q_blk, k).astype(jnp.float32)
        s = s * (HEAD_DIM ** -0.5)
        dist = (i * Q_BLOCK + jnp.arange(Q_BLOCK))[:, None] - kpos[None, :]
        s = s - slopes[None, :, None, None, None] * dist.astype(jnp.float32)
        s = jnp.where(dist >= 0, s, -jnp.inf)
        p = jax.nn.softmax(s, axis=-1)
        p_diff = p[:, :, 0] - lam * p[:, :, 1]
        return jnp.einsum("bhqk,bkhe->bqhe", p_diff.astype(v.dtype), v)

    out = lax.map(block, (qb, jnp.arange(nb)))
    out = out.transpose(1, 0, 2, 3, 4).reshape(B, S, DIFF_HEADS, DIFF_V_DIM)
    out = rms_norm(out, subln_g) * (1.0 - lambda_init)
    return out.reshape(B, S, DIFF_HEADS * DIFF_V_DIM)


def conv_ffn(h, w_up, conv_w, conv_b, w_down):
    u = jnp.einsum("bsd,df->bsf", h, w_up)
    up = jnp.pad(u, ((0, 0), (CONV_WIDTH - 1, 0), (0, 0)))
    S = u.shape[1]
    c = (conv_w[0] * up[:, 0:S] + conv_w[1] * up[:, 1:S + 1]
         + conv_w[2] * up[:, 2:S + 2] + conv_b)
    g, val = jnp.split(c, 2, axis=-1)
    return jnp.einsum("bsf,fd->bsd", jax.nn.gelu(g, approximate=True) * val, w_down)


def setup_inputs(seed: int = 0) -> dict:
    key = jax.random.key(seed)
    ks = jax.random.split(key, 18)
    f32 = jnp.float32

    def nrm(k, shape, scale):
        return jax.random.normal(k, shape, f32) * scale

    def gain(k, shape):
        return 1.0 + 0.05 * jax.random.normal(k, shape, f32)

    return {
        "x": nrm(ks[0], (BATCH, SEQ, D_MODEL), 1.0),
        "attn_pre_g": gain(ks[1], (DEPTH, D_MODEL)),
        "w_in": nrm(ks[2], (DEPTH, D_MODEL, IN_COLS), D_MODEL ** -0.5),
        "swa_sinks": nrm(ks[3], (DEPTH, SWA_Q_HEADS), 0.5),
        "swa_out_g": gain(ks[4], (DEPTH, SWA_WIDTH)),
        "diff_lq1": nrm(ks[5], (DEPTH, HEAD_DIM), 0.1),
        "diff_lk1": nrm(ks[6], (DEPTH, HEAD_DIM), 0.1),
        "diff_lq2": nrm(ks[7], (DEPTH, HEAD_DIM), 0.1),
        "diff_lk2": nrm(ks[8], (DEPTH, HEAD_DIM), 0.1),
        "diff_subln_g": gain(ks[9], (DEPTH, DIFF_V_DIM)),
        "w_out": nrm(ks[10], (DEPTH, MIX_WIDTH, D_MODEL), MIX_WIDTH ** -0.5),
        "attn_post_g": gain(ks[11], (DEPTH, D_MODEL)),
        "ffn_pre_g": gain(ks[12], (DEPTH, D_MODEL)),
        "w_up": nrm(ks[13], (DEPTH, D_MODEL, 2 * D_FF), D_MODEL ** -0.5),
        "conv_w": nrm(ks[14], (DEPTH, CONV_WIDTH, 2 * D_FF), CONV_WIDTH ** -0.5),
        "conv_b": nrm(ks[15], (DEPTH, 2 * D_FF), 0.02),
        "w_down": nrm(ks[16], (DEPTH, D_FF, D_MODEL), D_FF ** -0.5),
        "ffn_post_g": gain(ks[17], (DEPTH, D_MODEL)),
    }


def reference(x, attn_pre_g, w_in, swa_sinks, swa_out_g, diff_lq1, diff_lk1, diff_lq2,
              diff_lk2, diff_subln_g, w_out, attn_post_g, ffn_pre_g, w_up, conv_w, conv_b,
              w_down, ffn_post_g):
    B, S = x.shape[0], x.shape[1]
    slopes = jnp.asarray(alibi_slopes(SWA_Q_HEADS + DIFF_HEADS))
    swa_slopes = slopes[:SWA_Q_HEADS]
    diff_slopes = slopes[SWA_Q_HEADS:]
    for layer in range(DEPTH):
        lambda_init = 0.8 - 0.6 * math.exp(-0.3 * layer)
        h = rms_norm(x, attn_pre_g[layer])
        proj = jnp.einsum("bsd,de->bse", h, w_in[layer])
        q_a, k_a, v_a, q_b, k_b, v_b = jnp.split(proj, IN_SPLITS, axis=-1)
        y_a = swa_sink_attention(
            q_a.reshape(B, S, SWA_Q_HEADS, HEAD_DIM),
            k_a.reshape(B, S, SWA_KV_HEADS, HEAD_DIM),
            v_a.reshape(B, S, SWA_KV_HEADS, HEAD_DIM),
            swa_sinks[layer], swa_slopes)
        y_a = rms_norm(y_a, swa_out_g[layer])
        lam = (jnp.exp(jnp.sum(diff_lq1[layer].astype(jnp.float32) * diff_lk1[layer].astype(jnp.float32)))
               - jnp.exp(jnp.sum(diff_lq2[layer].astype(jnp.float32) * diff_lk2[layer].astype(jnp.float32)))
               + lambda_init)
        y_b = diff_attention(
            q_b.reshape(B, S, DIFF_HEADS, 2, HEAD_DIM),
            k_b.reshape(B, S, DIFF_HEADS, 2, HEAD_DIM),
            v_b.reshape(B, S, DIFF_HEADS, DIFF_V_DIM),
            lam, diff_slopes, diff_subln_g[layer], lambda_init)
        mix = jnp.concatenate([y_a, y_b], axis=-1)
        x = x + rms_norm(jnp.einsum("bse,ed->bsd", mix, w_out[layer]), attn_post_g[layer])
        h2 = rms_norm(x, ffn_pre_g[layer])
        f = conv_ffn(h2, w_up[layer], conv_w[layer], conv_b[layer], w_down[layer])
        x = x + rms_norm(f, ffn_post_g[layer])
    return x
```

```cpp
#include <hip/hip_runtime.h>
#include <hip/hip_cooperative_groups.h>
#include <hip/hip_bf16.h>
#include <cstdio>
#include <cstdint>
namespace cg = cooperative_groups;

namespace pg8 {
#define PG8_LAS __attribute__((address_space(3)))
typedef unsigned short bf16_t;
typedef short bf16x8 __attribute__((ext_vector_type(8)));
typedef float f32x4 __attribute__((ext_vector_type(4)));
typedef unsigned u32x4 __attribute__((ext_vector_type(4)));
constexpr int BM = 256, BK = 64, HALF = 128, HTB = HALF * BK * 2  , STAGE_BYTES = 8 * HTB, NXCD = 8, WGM = 8;

__host__ __device__ __forceinline__ int lds_byte(int r, int c) { const int st = (r >> 4) * 2 + (c >> 5), rr = r & 15, cc = c & 31, ob = rr * 64 + cc * 2; return st * 1024 + (ob ^ (((ob >> 9) & 1) << 5)); }
__host__ __device__ __forceinline__ void stage_rc(int b, int& R, int& C) { const int st = b / 1024, sb = b % 1024, swz = sb ^ (((sb >> 9) & 1) << 5); R = (st >> 1) * 16 + swz / 64; C = (st & 1) * 32 + (swz % 64) / 2; }
__host__ __device__ __forceinline__ int perm32(int rho) { const int n = rho >> 4, i = rho & 15; return 8 * (i >> 2) + 4 * n + (i & 3); }

struct Unit { int pm, pn; };
struct Gemm { const bf16_t* A; const bf16_t* Bt; int M, N, K; };

struct StaticOrder {
    int nM, nN, nwg, G, c;
    __host__ __device__ void init(int M, int N, int G_, int c_) { nM = M / BM; nN = N / BM; nwg = nM * nN; G = G_; c = c_; }
    __host__ __device__ bool next(int i, Unit& u) const {
        const long L = (long)i * G + c; if (L >= nwg) return false;
        int wgid = (int)L; { const int q = nwg / NXCD, r = nwg % NXCD, xcd = wgid % NXCD, off = wgid / NXCD; wgid = (xcd < r ? xcd * (q + 1) : r * (q + 1) + (xcd - r) * q) + off; }
        const int nig = WGM * nN, gid = wgid / nig, fm = gid * WGM, gsz = (nM - fm) < WGM ? (nM - fm) : WGM;
        u.pm = fm + ((wgid % nig) % gsz); u.pn = (wgid % nig) / gsz; return true;
    }
    __device__ __forceinline__ void a_ready(const Unit&) const {}
    __device__ __forceinline__ void done(const Unit&) const {}
};
__device__ __forceinline__ unsigned cvt_pk_bf16(float lo, float hi) { unsigned r; asm volatile("v_cvt_pk_bf16_f32 %0, %1, %2" : "=v"(r) : "v"(lo), "v"(hi)); return r; }
typedef float f32x2 __attribute__((ext_vector_type(2)));
__device__ __forceinline__ f32x2 gelu_pk(f32x2 v) {
    const f32x2 av = __builtin_elementwise_abs(v), d = av * 0.2316418882f + 1.0f;
    f32x2 t; t.x = __builtin_amdgcn_rcpf(d.x); t.y = __builtin_amdgcn_rcpf(d.y);
    f32x2 q = t * 0.5307027145f + (-0.7265760135f); q = q * t + 0.7107068705f; q = q * t + (-0.142248368f); q = q * t + 0.127414796f; q = q * t;
    const f32x2 s = (v * v) * (-0.72134752044f);
    f32x2 e; e.x = __builtin_amdgcn_exp2f(s.x); e.y = __builtin_amdgcn_exp2f(s.y);
    const f32x2 m = v * (q * e), r = v - m;
    f32x2 o; o.x = v.x < 0.f ? m.x : r.x; o.y = v.y < 0.f ? m.y : r.y; return o;
}

template <int ACT  > struct EpiBf16 {
    static constexpr bool PERM = true, AFTER_DRAIN = false; static_assert(ACT == 0 || ACT == 1, "EpiBf16: ACT is 0 (none) or 1 (gelu_pk)");
    bf16_t* O; int ldc; const float* bias; int split_cols; size_t split_stride; float scale0;
    __device__ __forceinline__ void operator()(const f32x4 (&acc)[2][2][4][2], const Unit& u, int wr, int wc, int fr, int fq) const {
        const int row0 = u.pm * BM + wr * 64 + fr; int colt = u.pn * BM; bf16_t* base = O;
        float sc = 1.f; if (split_cols) { const int t = colt / split_cols; base += (size_t)t * split_stride; colt -= t * split_cols; if (t == 0) sc = scale0; }
        const int col0 = colt + wc * 32 + 8 * fq, bcol0 = u.pn * BM + wc * 32 + 8 * fq;
        f32x4 bv[2][2];
#pragma unroll
        for (int bj = 0; bj < 2; ++bj)
#pragma unroll
            for (int n = 0; n < 2; ++n) bv[bj][n] = bias ? *(const f32x4*)(bias + bcol0 + bj * HALF + 4 * n) : (f32x4){0.f, 0.f, 0.f, 0.f};
#pragma unroll
        for (int ai = 0; ai < 2; ++ai)
#pragma unroll
            for (int m = 0; m < 4; ++m) { bf16_t* rowp = base + (size_t)(row0 + ai * HALF + m * 16) * ldc + col0;
#pragma unroll
                for (int bj = 0; bj < 2; ++bj) { f32x4 v0 = acc[ai][bj][m][0] + bv[bj][0], v1 = acc[ai][bj][m][1] + bv[bj][1];
                    if (ACT == 1) { f32x2 a = gelu_pk((f32x2){v0[0], v0[1]}), b = gelu_pk((f32x2){v0[2], v0[3]}), c = gelu_pk((f32x2){v1[0], v1[1]}), d = gelu_pk((f32x2){v1[2], v1[3]});
                        v0 = (f32x4){a.x, a.y, b.x, b.y}; v1 = (f32x4){c.x, c.y, d.x, d.y}; }
                    v0 = v0 * sc; v1 = v1 * sc; u32x4 w; w.x = cvt_pk_bf16(v0[0], v0[1]); w.y = cvt_pk_bf16(v0[2], v0[3]); w.z = cvt_pk_bf16(v1[0], v1[1]); w.w = cvt_pk_bf16(v1[2], v1[3]);
                    *(u32x4*)(rowp + bj * HALF) = w; } }
    }
};

struct EpiProj {
    static constexpr bool PERM = true, AFTER_DRAIN = false;
    bf16_t *QA, *KA, *VA, *QB, *KB, *VB;
    __device__ __forceinline__ void operator()(const f32x4 (&acc)[2][2][4][2], const Unit& u, int wr, int wc, int fr, int fq) const {
        const int pn = u.pn;
        const int b = u.pm >> 5;
#pragma unroll
        for (int bj = 0; bj < 2; ++bj) {
            bf16_t* base; int rstride; float beta = 0.f; int mode = 0;
            if (pn < 2)       { base = QA + pn * 256 + bj * 128 + wc * 32 + fq * 8; rstride = 512; }
            else if (pn == 2) { base = (bj == 0 ? KA : VA) + wc * 32 + fq * 8; rstride = 128; }
            else if (pn < 5)  { base = QB + (pn - 3) * 256 + bj * 128 + wc * 32 + fq * 8; rstride = 512; }
            else if (pn < 7)  { const int h = 2 * (pn - 5) + bj, mm = wc >> 1, c = 4 * (wc & 1) + fq; mode = 1; rstride = 0;
                                base = KB + ((size_t)((b * 4 + h) * 2 + mm) * 128) * 4096 + c * 512; }
            else              { const int h = 2 * (pn - 7) + bj; mode = 2; rstride = 0; beta = 1.4426950408889634f * __builtin_amdgcn_exp2f(-(float)(5 + h));
                                base = VB + ((size_t)(b * 4 + h) * 128) * 8192 + wc * 2048 + fq * 8; }
#pragma unroll
            for (int ai = 0; ai < 2; ++ai)
#pragma unroll
                for (int m = 0; m < 4; ++m) {
                    const int rl = ai * 128 + wr * 64 + m * 16 + fr;
                    const int row = u.pm * 256 + rl;
                    const int s = row & 8191, tile = s >> 6, key = s & 63;
                    f32x4 v0 = acc[ai][bj][m][0], v1 = acc[ai][bj][m][1];
                    bf16_t* p;
                    if (mode == 0) p = base + (size_t)row * rstride;
                    else if (mode == 1) p = base + (size_t)tile * 4096 + key * 8;
                    else { p = base + (size_t)tile * 8192 + (key >> 4) * 512 + (key & 15) * 32; const float w = __builtin_amdgcn_exp2f(beta * (float)key); v0 = v0 * w; v1 = v1 * w; }
                    u32x4 o; o.x = cvt_pk_bf16(v0[0], v0[1]); o.y = cvt_pk_bf16(v0[2], v0[3]); o.z = cvt_pk_bf16(v1[0], v1[1]); o.w = cvt_pk_bf16(v1[2], v1[3]);
                    *(u32x4*)p = o;
                }
        }
    }
};

__device__ __forceinline__ float dpp_shr1(float v) { return __int_as_float(__builtin_amdgcn_update_dpp(0, __float_as_int(v), 0x111, 0xf, 0xf, true)); }
__device__ __forceinline__ f32x4 dpp_shr1x4(f32x4 v) { return (f32x4){dpp_shr1(v[0]), dpp_shr1(v[1]), dpp_shr1(v[2]), dpp_shr1(v[3])}; }
__device__ __forceinline__ float gelu_tanh_gate(float x) {
    const float t = x * x, z = x * (2.3022081985f + 0.1029432397f * t);
    return x * __builtin_amdgcn_rcpf(1.0f + __builtin_amdgcn_exp2f(-z));
}
struct EpiConv {
    static constexpr bool PERM = true, AFTER_DRAIN = false;
    bf16_t* ACT; float* UB; const float* cw; const float* cb;
    __device__ __forceinline__ void operator()(const f32x4 (&acc)[2][2][4][2], const Unit& u, int wr, int wc, int fr, int fq) const {
        const int tok0 = u.pm * 256 + wr * 128 + fr * 8, span = u.pm * 2 + wr;
        unsigned keep[8][2];
#pragma unroll
        for (int n = 0; n < 2; ++n) {
            const int f = u.pn * 128 + wc * 32 + fq * 8 + n * 4;
            const f32x4 wg0 = *(const f32x4*)(cw + f), wg1 = *(const f32x4*)(cw + 8192 + f), wg2 = *(const f32x4*)(cw + 16384 + f), bg = *(const f32x4*)(cb + f);
            const f32x4 wv0 = *(const f32x4*)(cw + 4096 + f), wv1 = *(const f32x4*)(cw + 8192 + 4096 + f), wv2 = *(const f32x4*)(cw + 16384 + 4096 + f), bv = *(const f32x4*)(cb + 4096 + f);
#define UG(j) acc[(j) >> 2][0][(j) & 3][n]
#define UV(j) acc[(j) >> 2][1][(j) & 3][n]
            const f32x4 pg1 = dpp_shr1x4(UG(7)), pg2 = dpp_shr1x4(UG(6)), pv1 = dpp_shr1x4(UV(7)), pv2 = dpp_shr1x4(UV(6));
            if (fr == 0) { float* q = UB + (size_t)(span * 4) * 8192 + f; *(f32x4*)q = UG(0); *(f32x4*)(q + 8192) = UG(1); *(f32x4*)(q + 4096) = UV(0); *(f32x4*)(q + 8192 + 4096) = UV(1); }
            if (fr == 15) { float* q = UB + (size_t)(span * 4 + 2) * 8192 + f; *(f32x4*)q = UG(6); *(f32x4*)(q + 8192) = UG(7); *(f32x4*)(q + 4096) = UV(6); *(f32x4*)(q + 8192 + 4096) = UV(7); }
#pragma unroll
            for (int j = 0; j < 8; ++j) {
                const f32x4 g1 = j >= 1 ? UG(j >= 1 ? j - 1 : 0) : pg1, g2 = j >= 2 ? UG(j >= 2 ? j - 2 : 0) : (j == 1 ? pg1 : pg2);
                const f32x4 v1 = j >= 1 ? UV(j >= 1 ? j - 1 : 0) : pv1, v2 = j >= 2 ? UV(j >= 2 ? j - 2 : 0) : (j == 1 ? pv1 : pv2);
                const f32x4 cgv = bg + wg2 * UG(j) + wg1 * g1 + wg0 * g2;
                const f32x4 cvv = bv + wv2 * UV(j) + wv1 * v1 + wv0 * v2;
                const float a0 = gelu_tanh_gate(cgv[0]) * cvv[0], a1 = gelu_tanh_gate(cgv[1]) * cvv[1], a2 = gelu_tanh_gate(cgv[2]) * cvv[2], a3 = gelu_tanh_gate(cgv[3]) * cvv[3];
                const unsigned lo = cvt_pk_bf16(a0, a1), hi = cvt_pk_bf16(a2, a3);
                if (n == 0) { keep[j][0] = lo; keep[j][1] = hi; }
                else { u32x4 o; o.x = keep[j][0]; o.y = keep[j][1]; o.z = lo; o.w = hi; *(u32x4*)(ACT + (size_t)(tok0 + j) * 4096 + u.pn * 128 + wc * 32 + fq * 8) = o; }
            }
#undef UG
#undef UV
        }
    }
};
template <class Epi, class Sched, bool ALIGN_EPI = false, bool SP2 = false, bool ROWPERM = false>
__device__ __forceinline__ void gemm_phase(PG8_LAS unsigned char* lds, const Gemm g, const Sched& S, const Epi& E) {
    int tid_ = threadIdx.x; asm volatile("" : "+v"(tid_));
    const int tid = tid_, wid = __builtin_amdgcn_readfirstlane(tid >> 6), lane = tid & 63, wr = wid >> 2, wc = wid & 3, fr = lane & 15, fq = lane >> 4;
    const int K = g.K, nt = K / BK;
    unsigned voffA[2], voffB[2];
#pragma unroll
    for (int i = 0; i < 2; ++i) { int R, C; stage_rc(tid * 16 + i * 8192, R, C); const int Rb = Epi::PERM ? ((R & ~31) + perm32(R & 31)) : R;
        const int Ra = ROWPERM ? ((R >> 6) * 128 + (R & 15) * 8 + ((R >> 4) & 3)) : R;
        voffA[i] = (unsigned)(Ra * K + C) * 2u; voffB[i] = (unsigned)(Rb * K + C) * 2u; }
    const size_t kstep = (size_t)(BK * 2);
    const size_t hstepB = (size_t)HALF * K * 2;
    const size_t hstepA = ROWPERM ? (size_t)4 * K * 2 : hstepB;
    const size_t tstep = 2 * hstepB;
    const unsigned ldsw = (unsigned)wid * 1024u;
    const int aoff = lds_byte(wr * 64 + fr, fq * 8), boff = lds_byte(wc * 32 + fr, fq * 8);
#define PG8_SA(b, h) (((b) * 2 + (h)) * HTB)
#define PG8_SB(b, h) ((4 + (b) * 2 + (h)) * HTB)
#define PG8_STAGE(bufoff, gbase, voff) do { _Pragma("unroll") for (int _i = 0; _i < 2; ++_i) \
        __builtin_amdgcn_global_load_lds((const unsigned*)((const char*)(gbase) + (voff)[_i]), (PG8_LAS unsigned*)(lds + (bufoff) + ldsw + _i * 8192), 16, 0, 0); } while (0)
#define PG8_LDA(dst, b, h) do { _Pragma("unroll") for (int m = 0; m < 4; ++m) _Pragma("unroll") for (int k = 0; k < 2; ++k) dst[m][k] = *(const PG8_LAS bf16x8*)(lds + PG8_SA(b, h) + aoff + m * 2048 + k * 1024); } while (0)
#define PG8_LDB(dst, b, h) do { _Pragma("unroll") for (int n = 0; n < 2; ++n) _Pragma("unroll") for (int k = 0; k < 2; ++k) dst[n][k] = *(const PG8_LAS bf16x8*)(lds + PG8_SB(b, h) + boff + n * 2048 + k * 1024); } while (0)
#define PG8_MMA(ai, bj, At, Bt) do { __builtin_amdgcn_s_setprio(1); _Pragma("unroll") for (int m = 0; m < 4; ++m) _Pragma("unroll") for (int n = 0; n < 2; ++n) _Pragma("unroll") for (int k = 0; k < 2; ++k) \
        acc[ai][bj][m][n] = __builtin_amdgcn_mfma_f32_16x16x32_bf16(Bt[n][k], At[m][k], acc[ai][bj][m][n], 0, 0, 0); __builtin_amdgcn_s_setprio(0); } while (0)
#define PG8_WAIT_V(n) asm volatile("s_waitcnt vmcnt(" #n ")" ::: "memory")
#define PG8_WAIT_L(n) asm volatile("s_waitcnt lgkmcnt(" #n ")" ::: "memory")
#define PG8_BAR __builtin_amdgcn_s_barrier()
#define PG8_SCHED __builtin_amdgcn_sched_barrier(0)
    Unit cur, nxt; int ui = 0;
    if (!S.next(0, cur)) return;
    f32x4 acc[2][2][4][2];
#pragma unroll
    for (int a = 0; a < 2; ++a)
#pragma unroll
        for (int b = 0; b < 2; ++b)
#pragma unroll
            for (int m = 0; m < 4; ++m)
#pragma unroll
                for (int n = 0; n < 2; ++n) acc[a][b][m][n] = (f32x4){0.f, 0.f, 0.f, 0.f};
    bf16x8 At[4][2], B0[2][2], B1[2][2];
    const char* cA = (const char*)g.A + (size_t)cur.pm * tstep; const char* cB = (const char*)g.Bt + (size_t)cur.pn * tstep;
    S.a_ready(cur);
    if constexpr (SP2) {
        PG8_STAGE(PG8_SB(0, 0), cB, voffB); PG8_STAGE(PG8_SB(0, 1), cB + hstepB, voffB); PG8_STAGE(PG8_SA(0, 0), cA, voffA); PG8_STAGE(PG8_SA(0, 1), cA + hstepA, voffA);
        if (wr == 1) PG8_BAR;
        PG8_WAIT_V(2); PG8_BAR;
        PG8_STAGE(PG8_SB(1, 0), cB + kstep, voffB); PG8_STAGE(PG8_SA(1, 0), cA + kstep, voffA); PG8_STAGE(PG8_SB(1, 1), cB + hstepB + kstep, voffB);
        PG8_WAIT_V(6); PG8_BAR;
    } else {
        PG8_STAGE(PG8_SB(0, 0), cB, voffB); PG8_STAGE(PG8_SA(0, 0), cA, voffA); PG8_STAGE(PG8_SB(0, 1), cB + hstepB, voffB); PG8_STAGE(PG8_SA(0, 1), cA + hstepA, voffA);
        if (wr == 1) PG8_BAR;
        PG8_WAIT_V(4); PG8_BAR;
        PG8_STAGE(PG8_SB(1, 0), cB + kstep, voffB); PG8_STAGE(PG8_SA(1, 0), cA + kstep, voffA); PG8_STAGE(PG8_SB(1, 1), cB + hstepB + kstep, voffB);
        PG8_WAIT_V(6); PG8_BAR;
    }
    for (;;) {
        const bool has_next = S.next(ui + 1, nxt);
        const char* nA = has_next ? (const char*)g.A + (size_t)nxt.pm * tstep : cA; const char* nB = has_next ? (const char*)g.Bt + (size_t)nxt.pn * tstep : cB;
        for (int t = 0; t < nt; t += 2) {
            const bool last = (t == nt - 2);
            const char* a1 = cA + (size_t)(t + 1) * kstep;
            const char* a2 = last ? nA : cA + (size_t)(t + 2) * kstep; const char* b2 = last ? nB : cB + (size_t)(t + 2) * kstep;
            const char* a3 = a2 + kstep; const char* b3 = b2 + kstep;
            if (last && has_next) S.a_ready(nxt);
            if constexpr (SP2) {
            PG8_LDB(B0, 0, 0); PG8_LDB(B1, 0, 1); PG8_SCHED; PG8_LDA(At, 0, 0); PG8_STAGE(PG8_SA(1, 1), a1 + hstepA, voffA);
            PG8_WAIT_V(8); PG8_WAIT_L(0); PG8_BAR; PG8_MMA(0, 0, At, B0); PG8_MMA(0, 1, At, B1); PG8_BAR; PG8_SCHED;
            PG8_LDA(At, 0, 1); PG8_STAGE(PG8_SB(0, 0), b2, voffB); PG8_STAGE(PG8_SB(0, 1), b2 + hstepB, voffB); PG8_STAGE(PG8_SA(0, 0), a2, voffA);
            PG8_WAIT_V(8); PG8_WAIT_L(0); PG8_BAR; PG8_MMA(1, 0, At, B0); PG8_MMA(1, 1, At, B1); PG8_BAR; PG8_SCHED;
            PG8_LDB(B0, 1, 0); PG8_LDB(B1, 1, 1); PG8_SCHED; PG8_LDA(At, 1, 0); PG8_STAGE(PG8_SA(0, 1), a2 + hstepA, voffA);
            PG8_WAIT_V(8); PG8_WAIT_L(0); PG8_BAR; PG8_MMA(0, 0, At, B0); PG8_MMA(0, 1, At, B1); PG8_BAR; PG8_SCHED;
            PG8_LDA(At, 1, 1); PG8_STAGE(PG8_SB(1, 0), b3, voffB); PG8_STAGE(PG8_SB(1, 1), b3 + hstepB, voffB); PG8_STAGE(PG8_SA(1, 0), a3, voffA);
            PG8_WAIT_V(8); PG8_WAIT_L(0); PG8_BAR; PG8_MMA(1, 0, At, B0); PG8_MMA(1, 1, At, B1); PG8_BAR; PG8_SCHED;
            } else {
            PG8_LDB(B0, 0, 0); PG8_SCHED; PG8_LDA(At, 0, 0); PG8_STAGE(PG8_SA(1, 1), a1 + hstepA, voffA);
            PG8_WAIT_L(8); PG8_BAR; PG8_WAIT_L(0); PG8_MMA(0, 0, At, B0); PG8_BAR; PG8_SCHED;
            PG8_LDB(B1, 0, 1); PG8_STAGE(PG8_SB(0, 0), b2, voffB);
            PG8_BAR; PG8_WAIT_L(0); PG8_MMA(0, 1, At, B1); PG8_BAR;
            PG8_LDA(At, 0, 1); PG8_STAGE(PG8_SA(0, 0), a2, voffA);
            PG8_BAR; PG8_WAIT_L(0); PG8_MMA(1, 0, At, B0); PG8_BAR; PG8_SCHED;
            PG8_STAGE(PG8_SB(0, 1), b2 + hstepB, voffB);
            PG8_WAIT_V(6); PG8_BAR; PG8_MMA(1, 1, At, B1); PG8_BAR;
            PG8_LDB(B0, 1, 0); PG8_SCHED; PG8_LDA(At, 1, 0); PG8_STAGE(PG8_SA(0, 1), a2 + hstepA, voffA);
            PG8_WAIT_L(8); PG8_BAR; PG8_WAIT_L(0); PG8_MMA(0, 0, At, B0); PG8_BAR; PG8_SCHED;
            PG8_LDB(B1, 1, 1); PG8_STAGE(PG8_SB(1, 0), b3, voffB);
            PG8_BAR; PG8_WAIT_L(0); PG8_MMA(0, 1, At, B1); PG8_BAR;
            PG8_LDA(At, 1, 1); PG8_STAGE(PG8_SA(1, 0), a3, voffA);
            PG8_BAR; PG8_WAIT_L(0); PG8_MMA(1, 0, At, B0); PG8_BAR; PG8_SCHED;
            PG8_STAGE(PG8_SB(1, 1), b3 + hstepB, voffB);
            PG8_WAIT_V(6); PG8_BAR; PG8_MMA(1, 1, At, B1); PG8_BAR;
            }
        }
        if constexpr (ALIGN_EPI) { if (wr == 0) PG8_BAR; }
        if constexpr (!Epi::AFTER_DRAIN) { E(acc, cur, wr, wc, fr, fq); S.done(cur); }
        if (!has_next) break;
#pragma unroll
        for (int a = 0; a < 2; ++a)
#pragma unroll
            for (int b = 0; b < 2; ++b)
#pragma unroll
                for (int m = 0; m < 4; ++m)
#pragma unroll
                    for (int n = 0; n < 2; ++n) acc[a][b][m][n] = (f32x4){0.f, 0.f, 0.f, 0.f};
        cur = nxt; cA = nA; cB = nB; ++ui;
        if constexpr (ALIGN_EPI) { if (wr == 1) PG8_BAR; }
    }
    PG8_WAIT_V(0);
    if constexpr (!ALIGN_EPI) { if (wr == 0) PG8_BAR; }
    PG8_BAR;
    if constexpr (Epi::AFTER_DRAIN) { E.fused(acc, cur, wr, wc, fr, fq, lds, wid, lane); S.done(cur); }
#undef PG8_SA
#undef PG8_SB
#undef PG8_STAGE
#undef PG8_LDA
#undef PG8_LDB
#undef PG8_MMA
#undef PG8_WAIT_V
#undef PG8_WAIT_L
#undef PG8_BAR
#undef PG8_SCHED
}
}

namespace att {
#define LAS __attribute__((address_space(3)))
typedef unsigned short bf16;
typedef short bf16x8 __attribute__((ext_vector_type(8)));
typedef short s16x4 __attribute__((ext_vector_type(4)));
typedef float f32x16 __attribute__((ext_vector_type(16)));
typedef float f32x4 __attribute__((ext_vector_type(4)));
typedef unsigned u32x4 __attribute__((ext_vector_type(4)));
typedef unsigned u32x2 __attribute__((ext_vector_type(2)));
typedef float f32x2_t __attribute__((ext_vector_type(2)));
typedef __bf16 bf16x2_t __attribute__((ext_vector_type(2)));
typedef short v4i16_t __attribute__((ext_vector_type(4)));
typedef LAS const char* lds_cptr;
constexpr int SEQ = 8192;
constexpr float LOG2E = 1.4426950408889634f;
#define MFMA32(a, b, c) __builtin_amdgcn_mfma_f32_32x32x16_bf16(a, b, c, 0, 0, 0)
__device__ __forceinline__ int crow(int r, int hi) { return (r & 3) + 8 * (r >> 2) + 4 * hi; }
__device__ __forceinline__ unsigned cvtpk(float lo, float hi) { f32x2_t v = {lo, hi}; bf16x2_t b = __builtin_convertvector(v, bf16x2_t); return __builtin_bit_cast(unsigned, b); }
__device__ __forceinline__ void glds16(const void* gsrc, unsigned lds_dst) { unsigned keep;
    asm volatile("s_mov_b32 %0, m0\n\ts_mov_b32 m0, %2\n\ts_nop 0\n\tglobal_load_lds_dwordx4 %1, off\n\ts_mov_b32 m0, %0" : "=&s"(keep) : "v"(gsrc), "s"(lds_dst) : "memory"); }
__device__ __forceinline__ s16x4 vtr(lds_cptr p) { return __builtin_bit_cast(s16x4, __builtin_amdgcn_ds_read_tr16_b64_v4i16((LAS v4i16_t*)p)); }
__device__ __forceinline__ bf16x8 kfrag(lds_cptr p) { return *(const LAS bf16x8*)p; }
#define MX3(a, b, c) __builtin_fmaxf(__builtin_fmaxf((a), (b)), (c))
__device__ __forceinline__ float half_swap_max(float m) { auto rr = __builtin_amdgcn_permlane32_swap(__float_as_uint(m), __float_as_uint(m), false, false); return __builtin_fmaxf(__uint_as_float(rr[0]), __uint_as_float(rr[1])); }
__device__ __forceinline__ float half_swap_sum(float m) { auto rr = __builtin_amdgcn_permlane32_swap(__float_as_uint(m), __float_as_uint(m), false, false); return __uint_as_float(rr[0]) + __uint_as_float(rr[1]); }
__device__ __forceinline__ float rowmax2(const f32x16& p0, const f32x16& p1) {
    float a = MX3(p0[0], p0[1], p1[0]), b = MX3(p0[2], p0[3], p1[1]); a = MX3(a, p1[2], p1[3]);
#pragma unroll
    for (int r = 4; r < 16; r += 4) { a = MX3(a, p0[r], p0[r + 1]); b = MX3(b, p0[r + 2], p0[r + 3]); a = MX3(a, p1[r], p1[r + 1]); b = MX3(b, p1[r + 2], p1[r + 3]); }
    return half_swap_max(__builtin_fmaxf(a, b)); }
#define WAIT_BAR(N) asm volatile("s_waitcnt vmcnt(" #N ") lgkmcnt(0)\n\ts_barrier" ::: "memory")
#define PKF(P, i) cvtpk(P[i], P[i + 1])

constexpr int DK_SLOT = 8192, DV_SLOT = 16384, D_LDS_K = 0, D_LDS_V = 3 * DK_SLOT;
template <int THRL>
__device__ __forceinline__ void diff_pass(int b, int h, int m, int qb, const bf16* QB, const bf16* KB, const bf16* VB, char* shm, f32x16 (&o)[4], float& l_out) {
    int tid_ = threadIdx.x; asm volatile("" : "+v"(tid_));
    const int tid = tid_, lane = tid & 63, r32 = lane & 31, hi = lane >> 5; const int wid = __builtin_amdgcn_readfirstlane(tid >> 6);
    const long rowbase = (long)b * SEQ; const int q0 = qb * 256;
    const bf16* Qw = QB + (rowbase + q0 + wid * 32) * 512 + h * 128 + m * 64;
    const char* Kt = (const char*)KB + ((size_t)((b * 4 + h) * 2 + m) * 128) * 8192 + wid * 1024 + lane * 16;
    const char* Vt = (const char*)VB + ((size_t)(b * 4 + h) * 128) * 16384 + wid * 1024 + lane * 16;
    const unsigned lds0 = (unsigned)(uintptr_t)shm;
    const unsigned kdst = lds0 + D_LDS_K + wid * 1024, vdst = lds0 + D_LDS_V + wid * 1024;
#define DMA_T(t, s) do { glds16(Kt + (size_t)(t) * 8192, (unsigned)__builtin_amdgcn_readfirstlane(kdst + (s) * DK_SLOT)); \
        glds16(Vt + (size_t)(t) * 16384, (unsigned)__builtin_amdgcn_readfirstlane(vdst + (s) * DV_SLOT)); \
        glds16(Vt + (size_t)(t) * 16384 + 8192, (unsigned)__builtin_amdgcn_readfirstlane(vdst + (s) * DV_SLOT + 8192)); } while (0)
    const lds_cptr shm3 = (lds_cptr)shm;
    const lds_cptr kp0 = shm3 + D_LDS_K + hi * 1024 + r32 * 16;
    const lds_cptr vp0 = shm3 + D_LDS_V + ((lane >> 4) & 1) * 32 + (lane & 3) * 8 + (4 * hi + ((lane & 15) >> 2)) * 64;
    const int NT = 4 * (qb + 1);
    DMA_T(0, 0); DMA_T(1, 1);
    bf16x8 qr[4];
#pragma unroll
    for (int d0 = 0; d0 < 4; ++d0) qr[d0] = *reinterpret_cast<const bf16x8*>(&Qw[(long)r32 * 512 + d0 * 16 + hi * 8]);
    const float beta = LOG2E * __builtin_amdgcn_exp2f(-(float)(5 + h));
    const float B64 = 64.f * beta, W32 = __builtin_amdgcn_exp2f(32.f * beta), Whi = hi ? __builtin_amdgcn_exp2f(4.f * beta) : 1.f;
    float Wr[16];
#pragma unroll
    for (int r = 0; r < 16; ++r) Wr[r] = __uint_as_float(__builtin_amdgcn_readfirstlane(__float_as_uint(__builtin_amdgcn_exp2f(beta * (float)((r & 3) + 8 * (r >> 2))))));
#pragma unroll
    for (int d = 0; d < 4; ++d) o[d] = f32x16{};
    float nm = 0.f, l_reg = 0.f;
    const int qrel = wid * 32 + r32;
    int slot = 0, slot2 = 2;
#pragma unroll 1
    for (int t = 0; t < NT; ++t) {
        if (t + 1 < NT) WAIT_BAR(3); else WAIT_BAR(0);
        if (t + 2 < NT) DMA_T(t + 2, slot2);
        f32x16 ci;
#pragma unroll
        for (int r = 0; r < 16; ++r) ci[r] = nm;
        f32x16 p0, p1;
        const lds_cptr kp = kp0 + slot * DK_SLOT;
        p0 = MFMA32(kfrag(kp), qr[0], ci); p1 = MFMA32(kfrag(kp + 512), qr[0], ci);
#pragma unroll
        for (int d0 = 1; d0 < 4; ++d0) { p0 = MFMA32(kfrag(kp + d0 * 2048), qr[d0], p0); p1 = MFMA32(kfrag(kp + d0 * 2048 + 512), qr[d0], p1); }
        const int jb = t - (NT - 4);
        if (jb >= 0) {
            const int kb = 64 * jb + 4 * hi;
#pragma unroll
            for (int r = 0; r < 16; ++r) { const int kv = kb + (r & 3) + 8 * (r >> 2); if (kv > qrel) p0[r] = -INFINITY; if (kv + 32 > qrel) p1[r] = -INFINITY; }
        }
        const float rm = rowmax2(p0, p1);
        const float dl = (t == 0) ? rm : ((rm > (float)THRL) ? rm : 0.f);
        const float f = (t == 0) ? 1.f : __builtin_amdgcn_exp2f(-dl);
        nm -= dl; l_reg *= f;
#pragma unroll
        for (int r = 0; r < 16; ++r) { p0[r] -= dl; p1[r] -= dl; }
        if (__any(f != 1.f)) {
#pragma unroll
            for (int d = 0; d < 4; ++d)
#pragma unroll
                for (int r = 0; r < 16; ++r) o[d][r] *= f;
        }
        float s0 = 0.f, s1 = 0.f;
#pragma unroll
        for (int r = 0; r < 16; ++r) { p0[r] = __builtin_amdgcn_exp2f(p0[r]); p1[r] = __builtin_amdgcn_exp2f(p1[r]); s0 = __builtin_fmaf(p0[r], Wr[r], s0); s1 = __builtin_fmaf(p1[r], Wr[r], s1); }
        l_reg += Whi * (s0 + W32 * s1);
        u32x4 pw[4];
        pw[0] = (u32x4){PKF(p0, 0), PKF(p0, 2), PKF(p0, 4), PKF(p0, 6)}; pw[1] = (u32x4){PKF(p0, 8), PKF(p0, 10), PKF(p0, 12), PKF(p0, 14)};
        pw[2] = (u32x4){PKF(p1, 0), PKF(p1, 2), PKF(p1, 4), PKF(p1, 6)}; pw[3] = (u32x4){PKF(p1, 8), PKF(p1, 10), PKF(p1, 12), PKF(p1, 14)};
        const lds_cptr vp = vp0 + slot * DV_SLOT;
#pragma unroll
        for (int d0 = 0; d0 < 4; ++d0) {
#pragma unroll
            for (int ks = 0; ks < 4; ++ks) {
                const s16x4 lo = vtr(vp + d0 * 4096 + ks * 1024), hv = vtr(vp + d0 * 4096 + ks * 1024 + 512);
                const bf16x8 vf = (bf16x8){lo[0], lo[1], lo[2], lo[3], hv[0], hv[1], hv[2], hv[3]};
                o[d0] = MFMA32(vf, __builtin_bit_cast(bf16x8, pw[ks]), o[d0]);
            }
            __builtin_amdgcn_sched_barrier(0);
        }
        nm += B64;
        slot = (slot == 2) ? 0 : slot + 1; slot2 = (slot2 == 2) ? 0 : slot2 + 1;
    }
    l_out = half_swap_sum(l_reg);
    WAIT_BAR(0);
#undef DMA_T
}

__device__ __forceinline__ void diff_unit(int b, int h, int qb, const bf16* QB, const bf16* KB, const bf16* VB, bf16* MIX, float* stash, float lam, const float* subg, char* shm) {
    int tid_ = threadIdx.x; asm volatile("" : "+v"(tid_));
    const int tid = tid_, lane = tid & 63, r32 = lane & 31, hi = lane >> 5; const int wid = __builtin_amdgcn_readfirstlane(tid >> 6);
    f32x16 o[4]; float l;
#pragma unroll 1
    for (int m = 0; m < 2; ++m) {
        diff_pass<6>(b, h, m, qb, QB, KB, VB, shm, o, l);
        if (m == 0) {
            const float rl = __builtin_amdgcn_rcpf(l);
            f32x4* st = (f32x4*)stash + tid * 16;
#pragma unroll
            for (int d = 0; d < 4; ++d)
#pragma unroll
                for (int g = 0; g < 4; ++g) st[d * 4 + g] = (f32x4){o[d][4 * g] * rl, o[d][4 * g + 1] * rl, o[d][4 * g + 2] * rl, o[d][4 * g + 3] * rl};
        } else {
            const float rl = lam * __builtin_amdgcn_rcpf(l);
            const f32x4* st = (const f32x4*)stash + tid * 16; float ss = 0.f;
#pragma unroll
            for (int d = 0; d < 4; ++d)
#pragma unroll
                for (int g = 0; g < 4; ++g) { const f32x4 a = st[d * 4 + g];
#pragma unroll
                    for (int e = 0; e < 4; ++e) { const float v = a[e] - o[d][4 * g + e] * rl; o[d][4 * g + e] = v; ss = __builtin_fmaf(v, v, ss); } }
            ss = half_swap_sum(ss);
            const float rs = 0.8f * __builtin_amdgcn_rsqf(ss * (1.0f / 128.0f) + 1e-6f);
            bf16* orow = MIX + ((long)b * SEQ + qb * 256 + wid * 32 + r32) * 1024 + 512 + h * 128 + 4 * hi;
#pragma unroll
            for (int d = 0; d < 4; ++d)
#pragma unroll
                for (int g = 0; g < 4; ++g) { const f32x4 gg = *(const f32x4*)(subg + 32 * d + 8 * g + 4 * hi);
                    u32x2 w; w.x = cvtpk(o[d][4 * g] * rs * gg[0], o[d][4 * g + 1] * rs * gg[1]); w.y = cvtpk(o[d][4 * g + 2] * rs * gg[2], o[d][4 * g + 3] * rs * gg[3]);
                    *(u32x2*)(orow + 32 * d + 8 * g) = w; }
        }
    }
}

__device__ __forceinline__ void swa_unit(int b, int nb, const bf16* QA, const bf16* KA, const bf16* VA, bf16* MIX, const float* sinks, const float* gain, char* shm, int ss_off) {
    int tid_ = threadIdx.x; asm volatile("" : "+v"(tid_));
    const int tid = tid_, lane = tid & 63, r32 = lane & 31, hi = lane >> 5; const int wid = __builtin_amdgcn_readfirstlane(tid >> 6);
    const long t0 = (long)b * SEQ + nb * 128;
    LAS char* sh = (LAS char*)shm;
#pragma unroll 4
    for (int i = 0; i < 16; ++i) {
        const int p = i * 512 + tid, kvh = p >> 12, rem = p & 4095, isV = rem >> 11, r2 = rem & 2047, key = r2 >> 3, c = r2 & 7;
        const bool valid = (nb > 0) || key >= 128;
        const bf16* src = (isV ? VA : KA) + (t0 - 128 + key) * 128 + kvh * 64 + c * 8;
        u32x4 v = (u32x4){0u, 0u, 0u, 0u}; if (valid) v = *(const u32x4*)src;
        const int dst = isV ? (65536 + kvh * 32768 + (c >> 2) * 16384 + (key >> 4) * 1024 + (key & 15) * 64 + (c & 3) * 16) : (kvh * 32768 + c * 4096 + key * 16);
        *(LAS u32x4*)(sh + dst) = v;
    }
    __syncthreads();
    const int hq = wid, kvh = wid >> 2;
    const float slope2 = LOG2E * __builtin_amdgcn_exp2f(-0.5f * (float)(hq + 1)), sink2 = sinks[hq] * LOG2E;
    const lds_cptr Kf = (lds_cptr)shm + kvh * 32768 + hi * 4096 + r32 * 16;
    const lds_cptr Vf = (lds_cptr)shm + 65536 + kvh * 32768 + ((lane >> 4) & 1) * 32 + (lane & 3) * 8 + (4 * hi + ((lane & 15) >> 2)) * 64;
    LAS float* SS = (LAS float*)(sh + ss_off);
    for (int i = 0; i < 4; ++i) {
        const bf16* Qw = QA + (t0 + 32 * i + r32) * 512 + hq * 64 + hi * 8;
        bf16x8 qr[4];
#pragma unroll
        for (int d0 = 0; d0 < 4; ++d0) qr[d0] = *reinterpret_cast<const bf16x8*>(Qw + d0 * 16);
        f32x16 s[5];
#pragma unroll
        for (int c5 = 0; c5 < 5; ++c5) {
            const int ch = i + c5; const lds_cptr kp = Kf + ch * 512;
            f32x16 a = f32x16{};
#pragma unroll
            for (int d0 = 0; d0 < 4; ++d0) a = MFMA32(kfrag(kp + d0 * 8192), qr[d0], a);
            const int base = 128 + 32 * i + r32 - 32 * ch - 4 * hi;
#pragma unroll
            for (int r = 0; r < 16; ++r) { const int dist = base - ((r & 3) + 8 * (r >> 2)); const int fk = 32 * ch + 4 * hi + (r & 3) + 8 * (r >> 2);
                const bool ok = dist >= 0 && dist < 128 && (nb > 0 || fk >= 128);
                a[r] = ok ? a[r] - slope2 * (float)dist : -INFINITY; }
            s[c5] = a;
        }
        float mx = sink2;
#pragma unroll
        for (int c5 = 0; c5 < 5; ++c5)
#pragma unroll
            for (int r = 0; r < 16; r += 2) mx = MX3(mx, s[c5][r], s[c5][r + 1]);
        mx = half_swap_max(mx);
        float ls = 0.f;
#pragma unroll
        for (int c5 = 0; c5 < 5; ++c5)
#pragma unroll
            for (int r = 0; r < 16; ++r) { s[c5][r] = __builtin_amdgcn_exp2f(s[c5][r] - mx); ls += s[c5][r]; }
        ls = half_swap_sum(ls) + __builtin_amdgcn_exp2f(sink2 - mx);
        f32x16 o[2]; o[0] = f32x16{}; o[1] = f32x16{};
#pragma unroll
        for (int c5 = 0; c5 < 5; ++c5)
#pragma unroll
            for (int k2 = 0; k2 < 2; ++k2) {
                const u32x4 pw = (u32x4){PKF(s[c5], 8 * k2), PKF(s[c5], 8 * k2 + 2), PKF(s[c5], 8 * k2 + 4), PKF(s[c5], 8 * k2 + 6)};
                const int kg = 2 * (i + c5) + k2;
#pragma unroll
                for (int d0 = 0; d0 < 2; ++d0) {
                    const s16x4 lo = vtr(Vf + d0 * 16384 + kg * 1024), hv = vtr(Vf + d0 * 16384 + kg * 1024 + 512);
                    const bf16x8 vf = (bf16x8){lo[0], lo[1], lo[2], lo[3], hv[0], hv[1], hv[2], hv[3]};
                    o[d0] = MFMA32(vf, __builtin_bit_cast(bf16x8, pw), o[d0]);
                }
            }
        const float rl = __builtin_amdgcn_rcpf(ls); float ss = 0.f;
        bf16* orow = MIX + (t0 + 32 * i + r32) * 1024 + hq * 64 + 4 * hi;
#pragma unroll
        for (int d0 = 0; d0 < 2; ++d0)
#pragma unroll
            for (int g = 0; g < 4; ++g) {
                const float y0 = o[d0][4 * g] * rl, y1 = o[d0][4 * g + 1] * rl, y2 = o[d0][4 * g + 2] * rl, y3 = o[d0][4 * g + 3] * rl;
                ss += (y0 * y0 + y1 * y1) + (y2 * y2 + y3 * y3);
                u32x2 w; w.x = cvtpk(y0, y1); w.y = cvtpk(y2, y3); *(u32x2*)(orow + 32 * d0 + 8 * g) = w; }
        ss = half_swap_sum(ss);
        if (hi == 0) SS[(32 * i + r32) * 8 + hq] = ss;
    }
    __syncthreads();
#pragma unroll 4
    for (int i = 0; i < 16; ++i) {
        const int idx = i * 512 + tid, row = idx >> 6, chn = idx & 63;
        const f32x4 sa = *(const LAS f32x4*)(SS + row * 8), sb = *(const LAS f32x4*)(SS + row * 8 + 4);
        const float tot = (sa[0] + sa[1]) + (sa[2] + sa[3]) + (sb[0] + sb[1]) + (sb[2] + sb[3]);
        const float rr = __builtin_amdgcn_rsqf(tot * (1.0f / 512.0f) + 1e-6f);
        u32x4* pp = (u32x4*)(MIX + (t0 + row) * 1024 + chn * 8); const u32x4 v = *pp;
        const f32x4 g0 = *(const f32x4*)(gain + chn * 8), g1 = *(const f32x4*)(gain + chn * 8 + 4);
        u32x4 w;
        w.x = cvtpk(__uint_as_float(v.x << 16) * rr * g0[0], __uint_as_float(v.x & 0xffff0000u) * rr * g0[1]);
        w.y = cvtpk(__uint_as_float(v.y << 16) * rr * g0[2], __uint_as_float(v.y & 0xffff0000u) * rr * g0[3]);
        w.z = cvtpk(__uint_as_float(v.z << 16) * rr * g1[0], __uint_as_float(v.z & 0xffff0000u) * rr * g1[1]);
        w.w = cvtpk(__uint_as_float(v.w << 16) * rr * g1[2], __uint_as_float(v.w & 0xffff0000u) * rr * g1[3]);
        *pp = w;
    }
    __syncthreads();
}
#undef WAIT_BAR
#undef PKF
#undef MX3
#undef MFMA32
}

constexpr int NWAVES = 8;
constexpr int BATCH = 4, SEQ = 8192, DM = 1024, MTOK = BATCH * SEQ;
constexpr int NPROJ = 2304, DFF = 4096, NUP = 2 * DFF;
constexpr float EPS = 1e-6f, LOG2E_F = 1.4426950408889634f, QSCALE = 0.125f * 1.4426950408889634f;
constexpr size_t MiB = 1u << 20;
constexpr size_t WS_CTL = 0, WS_WIN = 1 * MiB, WS_WOUT = 6 * MiB, WS_WUP = 8 * MiB, WS_WDN = 24 * MiB, WS_XN = 32 * MiB;
constexpr size_t WS_QA = 96 * MiB, WS_KA = 128 * MiB, WS_VA = 136 * MiB, WS_QB = 144 * MiB, WS_KB = 176 * MiB, WS_VB = 208 * MiB, WS_MIX = 240 * MiB, WS_STASH = 304 * MiB;
constexpr size_t WS_ORAW = 96 * MiB, WS_ACT = 96 * MiB, WS_UB = 352 * MiB, WS_FRAW = 384 * MiB, WS_END = 448 * MiB;
constexpr int RING_BYTES = 131072, SS_OFF = RING_BYTES, LDS_BYTES = 147456;

#define GAS __attribute__((address_space(1)))
typedef unsigned short bf16;
typedef unsigned v4u __attribute__((ext_vector_type(4)));
typedef unsigned v2u __attribute__((ext_vector_type(2)));
typedef float f32x4 __attribute__((ext_vector_type(4)));
#define LDS_WAIT() asm volatile("s_waitcnt lgkmcnt(0)" ::: "memory")
__device__ __forceinline__ unsigned f2bf(float f) { unsigned u = __builtin_bit_cast(unsigned, f); return (u + 0x7fffu + ((u >> 16) & 1u)) >> 16; }
__device__ __forceinline__ unsigned pk2(float lo, float hi) { return f2bf(lo) | (f2bf(hi) << 16); }
__device__ __forceinline__ float bflo(unsigned w) { return __uint_as_float(w << 16); }
__device__ __forceinline__ float bfhi(unsigned w) { return __uint_as_float(w & 0xffff0000u); }
__device__ __forceinline__ float wave_sum(float v) {
#pragma unroll
    for (int o = 1; o < 64; o <<= 1) v += __shfl_xor(v, o);
    return v;
}
template <int MODE>
__device__ __forceinline__ void p0_transpose_item(const float* W, int K, int N, bf16* WT, const float* gain, LAS float* scr, int item, int lane) {
    const int nblk = N / 32, kb = item / nblk, nb = item % nblk, k0 = 64 * kb, n0 = 32 * nb;
#pragma unroll 8
    for (int i = 0; i < 32; ++i) { const int kk = 2 * i + (lane >> 5); float w = W[(size_t)(k0 + kk) * N + n0 + (lane & 31)]; if (MODE != 0) w *= gain[k0 + kk]; scr[kk * 33 + (lane & 31)] = w; }
    LDS_WAIT(); asm volatile("" ::: "memory");
    float cs = 1.f; if (MODE == 1) { if (n0 < 512 || (n0 >= 768 && n0 < 1280)) cs = QSCALE; }
    int r0 = n0; if (MODE == 2) { const int f = n0 & 4095; r0 = (f >> 7) * 256 + ((n0 >= 4096) ? 128 : 0) + (f & 127); }
    const int c = lane & 7;
#pragma unroll
    for (int j = 0; j < 4; ++j) { const int n = (lane >> 3) + 8 * j; const LAS float* s = scr + (8 * c) * 33 + n;
        v4u o; o.x = pk2(s[0 * 33] * cs, s[1 * 33] * cs); o.y = pk2(s[2 * 33] * cs, s[3 * 33] * cs); o.z = pk2(s[4 * 33] * cs, s[5 * 33] * cs); o.w = pk2(s[6 * 33] * cs, s[7 * 33] * cs);
        *(GAS v4u*)(WT + (size_t)(r0 + n) * K + k0 + 8 * c) = o; }
    LDS_WAIT(); asm volatile("" ::: "memory");
}
__device__ __forceinline__ void rms_row_to_bf16(const float* xrow, bf16* orow, int lane) {
    const GAS f32x4* xr = (const GAS f32x4*)xrow + lane;
    f32x4 v[4]; float s = 0.f;
#pragma unroll
    for (int j = 0; j < 4; ++j) { v[j] = xr[64 * j]; s += (v[j].x * v[j].x + v[j].y * v[j].y) + (v[j].z * v[j].z + v[j].w * v[j].w); }
    const float r = 1.0f / sqrtf(wave_sum(s) * (1.f / DM) + EPS);
    GAS v2u* o8 = (GAS v2u*)orow + lane;
#pragma unroll
    for (int j = 0; j < 4; ++j) { v2u w; w.x = pk2(v[j].x * r, v[j].y * r); w.y = pk2(v[j].z * r, v[j].w * r); o8[64 * j] = w; }
}
template <bool WITH_XN>
__device__ __forceinline__ void post_row(const bf16* raw, const float* base, const float* g, float* out, bf16* xn, int lane) {
    const GAS v2u* rr = (const GAS v2u*)raw + lane; const GAS f32x4* br = (const GAS f32x4*)base + lane; const GAS f32x4* gr = (const GAS f32x4*)g + lane;
    f32x4 o[4], xb[4]; float s = 0.f;
#pragma unroll
    for (int j = 0; j < 4; ++j) { const v2u w = rr[64 * j]; o[j] = (f32x4){bflo(w.x), bfhi(w.x), bflo(w.y), bfhi(w.y)}; xb[j] = br[64 * j]; s += (o[j].x * o[j].x + o[j].y * o[j].y) + (o[j].z * o[j].z + o[j].w * o[j].w); }
    const float r = 1.0f / sqrtf(wave_sum(s) * (1.f / DM) + EPS);
    float s2 = 0.f; GAS f32x4* orow = (GAS f32x4*)out + lane;
#pragma unroll
    for (int j = 0; j < 4; ++j) { const f32x4 gg = gr[64 * j]; xb[j] = xb[j] + o[j] * r * gg; orow[64 * j] = xb[j]; s2 += (xb[j].x * xb[j].x + xb[j].y * xb[j].y) + (xb[j].z * xb[j].z + xb[j].w * xb[j].w); }
    if (WITH_XN) {
        const float r2 = 1.0f / sqrtf(wave_sum(s2) * (1.f / DM) + EPS);
        GAS v2u* o8 = (GAS v2u*)xn + lane;
#pragma unroll
        for (int j = 0; j < 4; ++j) { v2u w; w.x = pk2(xb[j].x * r2, xb[j].y * r2); w.y = pk2(xb[j].z * r2, xb[j].w * r2); o8[64 * j] = w; }
    }
}

#ifndef PHASE_MASK
#define PHASE_MASK 0x1ff
#endif
#define PH(k) if ((PHASE_MASK >> (k)) & 1)
#define PHASE_LOCALS \
    int tid = threadIdx.x; asm volatile("" : "+v"(tid)); \
    const int lane = tid & 63, wave = __builtin_amdgcn_readfirstlane(tid >> 6); \
    int G = gridDim.x, bx = blockIdx.x; asm volatile("" : "+s"(G), "+s"(bx)); \
    const int vcu = (G % 8 == 0) ? (bx % 8) * (G / 8) + bx / 8 : bx; \
    unsigned char* ws = args.ws; asm volatile("" : "+s"(ws)); \
    const float* x = args.in[0]; \
    bf16* Wt_in = (bf16*)(ws + WS_WIN); bf16* Wt_out = (bf16*)(ws + WS_WOUT); bf16* Wt_up = (bf16*)(ws + WS_WUP); bf16* Wt_dn = (bf16*)(ws + WS_WDN); \
    bf16* XN = (bf16*)(ws + WS_XN); \
    bf16* QA = (bf16*)(ws + WS_QA); bf16* KA = (bf16*)(ws + WS_KA); bf16* VA = (bf16*)(ws + WS_VA); \
    bf16* QB = (bf16*)(ws + WS_QB); bf16* KB = (bf16*)(ws + WS_KB); bf16* VB = (bf16*)(ws + WS_VB); \
    bf16* MIX = (bf16*)(ws + WS_MIX); float* STASH = (float*)(ws + WS_STASH); \
    bf16* ORAW = (bf16*)(ws + WS_ORAW); bf16* ACT = (bf16*)(ws + WS_ACT); float* UB = (float*)(ws + WS_UB); bf16* FRAW = (bf16*)(ws + WS_FRAW); \
    LAS unsigned char* ldsl = (LAS unsigned char*)lds; \
    const int gw = vcu * NWAVES + wave, NGW = G * NWAVES; \
    (void)lane; (void)x; (void)Wt_in; (void)Wt_out; (void)Wt_up; (void)Wt_dn; (void)XN; (void)QA; (void)KA; (void)VA; (void)QB; (void)KB; (void)VB; (void)MIX; (void)STASH; (void)ORAW; (void)ACT; (void)UB; (void)FRAW; (void)ldsl; (void)gw; (void)NGW;
struct Args { const float* in[18]; float* out; unsigned char* ws; };

__global__ void __launch_bounds__(NWAVES * 64, 2) hymba_fwd(Args args) {
    extern __shared__ __attribute__((aligned(16))) unsigned char lds[];
    cg::grid_group grid = cg::this_grid();
    PH(0) { PHASE_LOCALS
        LAS float* scr = (LAS float*)(ldsl + wave * 16384);
        constexpr int I_IN = (DM / 64) * (NPROJ / 32), I_OUT = (DM / 64) * (DM / 32), I_UP = (DM / 64) * (NUP / 32), I_DN = (DFF / 64) * (DM / 32);
        constexpr int NITEMS = I_IN + I_OUT + I_UP + I_DN;
        for (int it = gw; it < NITEMS; it += NGW) {
            int r = it;
            if (r < I_IN) { p0_transpose_item<1>(args.in[2], DM, NPROJ, Wt_in, args.in[1], scr, r, lane); continue; } r -= I_IN;
            if (r < I_OUT) { p0_transpose_item<0>(args.in[10], DM, DM, Wt_out, nullptr, scr, r, lane); continue; } r -= I_OUT;
            if (r < I_UP) { p0_transpose_item<2>(args.in[13], DM, NUP, Wt_up, args.in[12], scr, r, lane); continue; } r -= I_UP;
            p0_transpose_item<0>(args.in[16], DFF, DM, Wt_dn, nullptr, scr, r, lane);
        }
        for (int m = gw; m < MTOK; m += NGW) rms_row_to_bf16(x + (size_t)m * DM, XN + (size_t)m * DM, lane);
    }
    grid.sync();

    PH(1) { PHASE_LOCALS
        pg8::Gemm g{XN, Wt_in, MTOK, NPROJ, DM}; pg8::StaticOrder S; S.init(MTOK, NPROJ, G, bx);
        pg8::EpiProj E{QA, KA, VA, QB, KB, VB};
        pg8::gemm_phase<pg8::EpiProj, pg8::StaticOrder, true, true>(ldsl, g, S, E);
    }
    grid.sync();

    PH(2) { PHASE_LOCALS
        const float d1 = wave_sum(args.in[5][lane] * args.in[6][lane]), d2 = wave_sum(args.in[7][lane] * args.in[8][lane]);
        const float lam = __expf(d1) - __expf(d2) + 0.2f;
#ifndef ATT_NO_SWA
        for (int u = vcu; u < BATCH * (SEQ / 128); u += G)
            att::swa_unit(u / (SEQ / 128), u % (SEQ / 128), QA, KA, VA, MIX, args.in[3], args.in[4], (char*)lds, SS_OFF);
#endif
#ifndef ATT_NO_DIFF
        for (int v = vcu; v < 256; v += G) {
            const int bh = v >> 4, s = v & 15;
            att::diff_unit(bh >> 2, bh & 3, s, QB, KB, VB, MIX, STASH + (size_t)bx * 32768, lam, args.in[9], (char*)lds);
            att::diff_unit(bh >> 2, bh & 3, 31 - s, QB, KB, VB, MIX, STASH + (size_t)bx * 32768, lam, args.in[9], (char*)lds);
        }
#endif
    }
    grid.sync();

    PH(3) { PHASE_LOCALS
        pg8::Gemm g{MIX, Wt_out, MTOK, DM, DM}; pg8::StaticOrder S; S.init(MTOK, DM, G, bx);
        pg8::EpiBf16<0> E{ORAW, DM, nullptr, 0, 0, 1.f};
        pg8::gemm_phase<pg8::EpiBf16<0>, pg8::StaticOrder, true, true>(ldsl, g, S, E);
    }
    grid.sync();
    PH(4) { PHASE_LOCALS
        for (int m = gw; m < MTOK; m += NGW) post_row<true>(ORAW + (size_t)m * DM, x + (size_t)m * DM, args.in[11], args.out + (size_t)m * DM, XN + (size_t)m * DM, lane); }
    grid.sync();

    PH(5) { PHASE_LOCALS
        pg8::Gemm g{XN, Wt_up, MTOK, NUP, DM}; pg8::StaticOrder S; S.init(MTOK, NUP, G, bx);
        pg8::EpiConv E{ACT, UB, args.in[14], args.in[15]};
        pg8::gemm_phase<pg8::EpiConv, pg8::StaticOrder, true, true, true>(ldsl, g, S, E);
    }
    grid.sync();
    PH(6) { PHASE_LOCALS
        const float* cw = args.in[14]; const float* cb = args.in[15];
        for (int it = bx * 512 + tid; it < 256 * 1024; it += G * 512) {
            const int span = it >> 10, f = (it & 1023) * 4;
            if ((span & 63) == 0) continue;
            const float* us = UB + (size_t)(span * 4) * 8192 + f; const float* up = UB + (size_t)((span - 1) * 4) * 8192 + f;
            float a0[4], a1[4];
            f32x4 cg0, cg1, cv0, cv1;
            { const f32x4 w0 = *(const f32x4*)(cw + f), w1 = *(const f32x4*)(cw + 8192 + f), w2 = *(const f32x4*)(cw + 16384 + f), bb = *(const f32x4*)(cb + f);
              const f32x4 u0 = *(const f32x4*)us, u1 = *(const f32x4*)(us + 8192), um2 = *(const f32x4*)(up + 2 * 8192), um1 = *(const f32x4*)(up + 3 * 8192);
              cg0 = bb + w2 * u0 + w1 * um1 + w0 * um2; cg1 = bb + w2 * u1 + w1 * u0 + w0 * um1; }
            { const f32x4 w0 = *(const f32x4*)(cw + 4096 + f), w1 = *(const f32x4*)(cw + 8192 + 4096 + f), w2 = *(const f32x4*)(cw + 16384 + 4096 + f), bb = *(const f32x4*)(cb + 4096 + f);
              const f32x4 u0 = *(const f32x4*)(us + 4096), u1 = *(const f32x4*)(us + 8192 + 4096), um2 = *(const f32x4*)(up + 2 * 8192 + 4096), um1 = *(const f32x4*)(up + 3 * 8192 + 4096);
              cv0 = bb + w2 * u0 + w1 * um1 + w0 * um2; cv1 = bb + w2 * u1 + w1 * u0 + w0 * um1; }
#pragma unroll
            for (int e = 0; e < 4; ++e) { a0[e] = pg8::gelu_tanh_gate(cg0[e]) * cv0[e]; a1[e] = pg8::gelu_tanh_gate(cg1[e]) * cv1[e]; }
            v2u w0; w0.x = pk2(a0[0], a0[1]); w0.y = pk2(a0[2], a0[3]); v2u w1; w1.x = pk2(a1[0], a1[1]); w1.y = pk2(a1[2], a1[3]);
            *(v2u*)(ACT + (size_t)(span * 128) * DFF + f) = w0; *(v2u*)(ACT + (size_t)(span * 128 + 1) * DFF + f) = w1;
        }
    }
    grid.sync();

    PH(7) { PHASE_LOCALS
        pg8::Gemm g{ACT, Wt_dn, MTOK, DM, DFF}; pg8::StaticOrder S; S.init(MTOK, DM, G, bx);
        pg8::EpiBf16<0> E{FRAW, DM, nullptr, 0, 0, 1.f};
        pg8::gemm_phase<pg8::EpiBf16<0>, pg8::StaticOrder, true, true>(ldsl, g, S, E);
    }
    grid.sync();
    PH(8) { PHASE_LOCALS
        for (int m = gw; m < MTOK; m += NGW) post_row<false>(FRAW + (size_t)m * DM, args.out + (size_t)m * DM, args.in[17], args.out + (size_t)m * DM, nullptr, lane); }
}

extern "C" void kernel_launch(void* const* d_in, const int* in_sizes, int n_in, void* d_out, int out_size, void* d_ws, size_t ws_size, hipStream_t stream) {
    static int grid = 0;
    if (grid == 0) {
        if (n_in != 18 || in_sizes[0] != MTOK * DM || out_size != MTOK * DM || ws_size < WS_END) {
            fprintf(stderr, "kernel_launch: unexpected problem shape (n_in %d, in0 %d, out %d, ws %zu); nothing launched\n", n_in, n_in > 0 ? in_sizes[0] : -1, out_size, ws_size); grid = -1; return; }
        int dev = 0, cus = 0, per_cu = 0;
        if (hipGetDevice(&dev) != hipSuccess || hipDeviceGetAttribute(&cus, hipDeviceAttributeMultiprocessorCount, dev) != hipSuccess) { grid = -1; return; }
        if (hipFuncSetAttribute((const void*)hymba_fwd, hipFuncAttributeMaxDynamicSharedMemorySize, LDS_BYTES) != hipSuccess) { fprintf(stderr, "kernel_launch: hipFuncSetAttribute failed\n"); grid = -1; return; }
        if (hipOccupancyMaxActiveBlocksPerMultiprocessor(&per_cu, (const void*)hymba_fwd, NWAVES * 64, LDS_BYTES) != hipSuccess || per_cu < 1) { fprintf(stderr, "kernel_launch: occupancy query says %d blocks per CU\n", per_cu); per_cu = 1; }
        (void)hipGetLastError();
        grid = cus;
    }
    if (grid < 0) return;
    Args a{};
    for (int i = 0; i < 18; ++i) a.in[i] = (const float*)d_in[i];
    a.out = (float*)d_out; a.ws = (unsigned char*)d_ws;
    void* kargs[] = {&a};
    hipError_t e = hipLaunchCooperativeKernel((const void*)hymba_fwd, dim3(grid), dim3(NWAVES * 64), kargs, LDS_BYTES, stream);
    if (e != hipSuccess) fprintf(stderr, "kernel_launch: cooperative launch failed: %s (grid %d)\n", hipGetErrorString(e), grid);
}
```

```cpp
#include <hip/hip_runtime.h>
#include <hip/hip_cooperative_groups.h>
#include <hip/hip_bf16.h>
#include <cstdio>
#include <cstdint>
namespace cg = cooperative_groups;

namespace pg8 {
#define PG8_LAS __attribute__((address_space(3)))
typedef unsigned short bf16_t;
typedef short bf16x8 __attribute__((ext_vector_type(8)));
typedef float f32x4 __attribute__((ext_vector_type(4)));
typedef unsigned u32x4 __attribute__((ext_vector_type(4)));
constexpr int BM = 256, BK = 64, HALF = 128, HTB = HALF * BK * 2  , STAGE_BYTES = 8 * HTB, NXCD = 8, WGM = 8;

__host__ __device__ __forceinline__ int lds_byte(int r, int c) { const int st = (r >> 4) * 2 + (c >> 5), rr = r & 15, cc = c & 31, ob = rr * 64 + cc * 2; return st * 1024 + (ob ^ (((ob >> 9) & 1) << 5)); }
__host__ __device__ __forceinline__ void stage_rc(int b, int& R, int& C) { const int st = b / 1024, sb = b % 1024, swz = sb ^ (((sb >> 9) & 1) << 5); R = (st >> 1) * 16 + swz / 64; C = (st & 1) * 32 + (swz % 64) / 2; }
__host__ __device__ __forceinline__ int perm32(int rho) { const int n = rho >> 4, i = rho & 15; return 8 * (i >> 2) + 4 * n + (i & 3); }

struct Unit { int pm, pn; };
struct Gemm { const bf16_t* A; const bf16_t* Bt; int M, N, K; };

struct StaticOrder {
    int nM, nN, nwg, G, c;
    __host__ __device__ void init(int M, int N, int G_, int c_) { nM = M / BM; nN = N / BM; nwg = nM * nN; G = G_; c = c_; }
    __host__ __device__ bool next(int i, Unit& u) const {
        const long L = (long)i * G + c; if (L >= nwg) return false;
        int wgid = (int)L; { const int q = nwg / NXCD, r = nwg % NXCD, xcd = wgid % NXCD, off = wgid / NXCD; wgid = (xcd < r ? xcd * (q + 1) : r * (q + 1) + (xcd - r) * q) + off; }
        const int nig = WGM * nN, gid = wgid / nig, fm = gid * WGM, gsz = (nM - fm) < WGM ? (nM - fm) : WGM;
        u.pm = fm + ((wgid % nig) % gsz); u.pn = (wgid % nig) / gsz; return true;
    }
    __device__ __forceinline__ void a_ready(const Unit&) const {}
    __device__ __forceinline__ void done(const Unit&) const {}
};
__device__ __forceinline__ unsigned cvt_pk_bf16(float lo, float hi) { unsigned r; asm volatile("v_cvt_pk_bf16_f32 %0, %1, %2" : "=v"(r) : "v"(lo), "v"(hi)); return r; }
typedef float f32x2 __attribute__((ext_vector_type(2)));
__device__ __forceinline__ f32x2 gelu_pk(f32x2 v) {
    const f32x2 av = __builtin_elementwise_abs(v), d = av * 0.2316418882f + 1.0f;
    f32x2 t; t.x = __builtin_amdgcn_rcpf(d.x); t.y = __builtin_amdgcn_rcpf(d.y);
    f32x2 q = t * 0.5307027145f + (-0.7265760135f); q = q * t + 0.7107068705f; q = q * t + (-0.142248368f); q = q * t + 0.127414796f; q = q * t;
    const f32x2 s = (v * v) * (-0.72134752044f);
    f32x2 e; e.x = __builtin_amdgcn_exp2f(s.x); e.y = __builtin_amdgcn_exp2f(s.y);
    const f32x2 m = v * (q * e), r = v - m;
    f32x2 o; o.x = v.x < 0.f ? m.x : r.x; o.y = v.y < 0.f ? m.y : r.y; return o;
}

template <int ACT  > struct EpiBf16 {
    static constexpr bool PERM = true, AFTER_DRAIN = false; static_assert(ACT == 0 || ACT == 1, "EpiBf16: ACT is 0 (none) or 1 (gelu_pk)");
    bf16_t* O; int ldc; const float* bias; int split_cols; size_t split_stride; float scale0;
    __device__ __forceinline__ void operator()(const f32x4 (&acc)[2][2][4][2], const Unit& u, int wr, int wc, int fr, int fq) const {
        const int row0 = u.pm * BM + wr * 64 + fr; int colt = u.pn * BM; bf16_t* base = O;
        float sc = 1.f; if (split_cols) { const int t = colt / split_cols; base += (size_t)t * split_stride; colt -= t * split_cols; if (t == 0) sc = scale0; }
        const int col0 = colt + wc * 32 + 8 * fq, bcol0 = u.pn * BM + wc * 32 + 8 * fq;
        f32x4 bv[2][2];
#pragma unroll
        for (int bj = 0; bj < 2; ++bj)
#pragma unroll
            for (int n = 0; n < 2; ++n) bv[bj][n] = bias ? *(const f32x4*)(bias + bcol0 + bj * HALF + 4 * n) : (f32x4){0.f, 0.f, 0.f, 0.f};
#pragma unroll
        for (int ai = 0; ai < 2; ++ai)
#pragma unroll
            for (int m = 0; m < 4; ++m) { bf16_t* rowp = base + (size_t)(row0 + ai * HALF + m * 16) * ldc + col0;
#pragma unroll
                for (int bj = 0; bj < 2; ++bj) { f32x4 v0 = acc[ai][bj][m][0] + bv[bj][0], v1 = acc[ai][bj][m][1] + bv[bj][1];
                    if (ACT == 1) { f32x2 a = gelu_pk((f32x2){v0[0], v0[1]}), b = gelu_pk((f32x2){v0[2], v0[3]}), c = gelu_pk((f32x2){v1[0], v1[1]}), d = gelu_pk((f32x2){v1[2], v1[3]});
                        v0 = (f32x4){a.x, a.y, b.x, b.y}; v1 = (f32x4){c.x, c.y, d.x, d.y}; }
                    v0 = v0 * sc; v1 = v1 * sc; u32x4 w; w.x = cvt_pk_bf16(v0[0], v0[1]); w.y = cvt_pk_bf16(v0[2], v0[3]); w.z = cvt_pk_bf16(v1[0], v1[1]); w.w = cvt_pk_bf16(v1[2], v1[3]);
                    *(u32x4*)(rowp + bj * HALF) = w; } }
    }
};

struct EpiProj {
    static constexpr bool PERM = true, AFTER_DRAIN = false;
    bf16_t *QA, *KA, *VA, *QB, *KB, *VB;
    __device__ __forceinline__ void operator()(const f32x4 (&acc)[2][2][4][2], const Unit& u, int wr, int wc, int fr, int fq) const {
        const int pn = u.pn;
        const int b = u.pm >> 5;
#pragma unroll
        for (int bj = 0; bj < 2; ++bj) {
            bf16_t* base; int rstride; float beta = 0.f; int mode = 0;
            if (pn < 2)       { base = QA + pn * 256 + bj * 128 + wc * 32 + fq * 8; rstride = 512; }
            else if (pn == 2) { base = (bj == 0 ? KA : VA) + wc * 32 + fq * 8; rstride = 128; }
            else if (pn < 5)  { base = QB + (pn - 3) * 256 + bj * 128 + wc * 32 + fq * 8; rstride = 512; }
            else if (pn < 7)  { const int h = 2 * (pn - 5) + bj, mm = wc >> 1, c = 4 * (wc & 1) + fq; mode = 1; rstride = 0;
                                base = KB + ((size_t)((b * 4 + h) * 2 + mm) * 128) * 4096 + c * 512; }
            else              { const int h = 2 * (pn - 7) + bj; mode = 2; rstride = 0; beta = 1.4426950408889634f * __builtin_amdgcn_exp2f(-(float)(5 + h));
                                base = VB + ((size_t)(b * 4 + h) * 128) * 8192 + wc * 2048 + fq * 8; }
#pragma unroll
            for (int ai = 0; ai < 2; ++ai)
#pragma unroll
                for (int m = 0; m < 4; ++m) {
                    const int rl = ai * 128 + wr * 64 + m * 16 + fr;
                    const int row = u.pm * 256 + rl;
                    const int s = row & 8191, tile = s >> 6, key = s & 63;
                    f32x4 v0 = acc[ai][bj][m][0], v1 = acc[ai][bj][m][1];
                    bf16_t* p;
                    if (mode == 0) p = base + (size_t)row * rstride;
                    else if (mode == 1) p = base + (size_t)tile * 4096 + key * 8;
                    else { p = base + (size_t)tile * 8192 + (key >> 4) * 512 + (key & 15) * 32; const float w = __builtin_amdgcn_exp2f(beta * (float)key); v0 = v0 * w; v1 = v1 * w; }
                    u32x4 o; o.x = cvt_pk_bf16(v0[0], v0[1]); o.y = cvt_pk_bf16(v0[2], v0[3]); o.z = cvt_pk_bf16(v1[0], v1[1]); o.w = cvt_pk_bf16(v1[2], v1[3]);
                    *(u32x4*)p = o;
                }
        }
    }
};

__device__ __forceinline__ float dpp_shr1(float v) { return __int_as_float(__builtin_amdgcn_update_dpp(0, __float_as_int(v), 0x111, 0xf, 0xf, true)); }
__device__ __forceinline__ f32x4 dpp_shr1x4(f32x4 v) { return (f32x4){dpp_shr1(v[0]), dpp_shr1(v[1]), dpp_shr1(v[2]), dpp_shr1(v[3])}; }
__device__ __forceinline__ float gelu_tanh_gate(float x) {
    const float t = x * x, z = x * (2.3022081985f + 0.1029432397f * t);
    return x * __builtin_amdgcn_rcpf(1.0f + __builtin_amdgcn_exp2f(-z));
}
struct EpiConv {
    static constexpr bool PERM = true, AFTER_DRAIN = false;
    bf16_t* ACT; float* UB; const float* cw; const float* cb;
    __device__ __forceinline__ void operator()(const f32x4 (&acc)[2][2][4][2], const Unit& u, int wr, int wc, int fr, int fq) const {
        const int tok0 = u.pm * 256 + wr * 128 + fr * 8, span = u.pm * 2 + wr;
        unsigned keep[8][2];
#pragma unroll
        for (int n = 0; n < 2; ++n) {
            const int f = u.pn * 128 + wc * 32 + fq * 8 + n * 4;
            const f32x4 wg0 = *(const f32x4*)(cw + f), wg1 = *(const f32x4*)(cw + 8192 + f), wg2 = *(const f32x4*)(cw + 16384 + f), bg = *(const f32x4*)(cb + f);
            const f32x4 wv0 = *(const f32x4*)(cw + 4096 + f), wv1 = *(const f32x4*)(cw + 8192 + 4096 + f), wv2 = *(const f32x4*)(cw + 16384 + 4096 + f), bv = *(const f32x4*)(cb + 4096 + f);
#define UG(j) acc[(j) >> 2][0][(j) & 3][n]
#define UV(j) acc[(j) >> 2][1][(j) & 3][n]
            const f32x4 pg1 = dpp_shr1x4(UG(7)), pg2 = dpp_shr1x4(UG(6)), pv1 = dpp_shr1x4(UV(7)), pv2 = dpp_shr1x4(UV(6));
            if (fr == 0) { float* q = UB + (size_t)(span * 4) * 8192 + f; *(f32x4*)q = UG(0); *(f32x4*)(q + 8192) = UG(1); *(f32x4*)(q + 4096) = UV(0); *(f32x4*)(q + 8192 + 4096) = UV(1); }
            if (fr == 15) { float* q = UB + (size_t)(span * 4 + 2) * 8192 + f; *(f32x4*)q = UG(6); *(f32x4*)(q + 8192) = UG(7); *(f32x4*)(q + 4096) = UV(6); *(f32x4*)(q + 8192 + 4096) = UV(7); }
#pragma unroll
            for (int j = 0; j < 8; ++j) {
                const f32x4 g1 = j >= 1 ? UG(j >= 1 ? j - 1 : 0) : pg1, g2 = j >= 2 ? UG(j >= 2 ? j - 2 : 0) : (j == 1 ? pg1 : pg2);
                const f32x4 v1 = j >= 1 ? UV(j >= 1 ? j - 1 : 0) : pv1, v2 = j >= 2 ? UV(j >= 2 ? j - 2 : 0) : (j == 1 ? pv1 : pv2);
                const f32x4 cgv = bg + wg2 * UG(j) + wg1 * g1 + wg0 * g2;
                const f32x4 cvv = bv + wv2 * UV(j) + wv1 * v1 + wv0 * v2;
                const float a0 = gelu_tanh_gate(cgv[0]) * cvv[0], a1 = gelu_tanh_gate(cgv[1]) * cvv[1], a2 = gelu_tanh_gate(cgv[2]) * cvv[2], a3 = gelu_tanh_gate(cgv[3]) * cvv[3];
                const unsigned lo = cvt_pk_bf16(a0, a1), hi = cvt_pk_bf16(a2, a3);
                if (n == 0) { keep[j][0] = lo; keep[j][1] = hi; }
                else { u32x4 o; o.x = keep[j][0]; o.y = keep[j][1]; o.z = lo; o.w = hi; *(u32x4*)(ACT + (size_t)(tok0 + j) * 4096 + u.pn * 128 + wc * 32 + fq * 8) = o; }
            }
#undef UG
#undef UV
        }
    }
};
template <class Epi, class Sched, bool ALIGN_EPI = false, bool SP2 = false, bool ROWPERM = false>
__device__ __forceinline__ void gemm_phase(PG8_LAS unsigned char* lds, const Gemm g, const Sched& S, const Epi& E) {
    int tid_ = threadIdx.x; asm volatile("" : "+v"(tid_));
    const int tid = tid_, wid = __builtin_amdgcn_readfirstlane(tid >> 6), lane = tid & 63, wr = wid >> 2, wc = wid & 3, fr = lane & 15, fq = lane >> 4;
    const int K = g.K, nt = K / BK;
    unsigned voffA[2], voffB[2];
#pragma unroll
    for (int i = 0; i < 2; ++i) { int R, C; stage_rc(tid * 16 + i * 8192, R, C); const int Rb = Epi::PERM ? ((R & ~31) + perm32(R & 31)) : R;
        const int Ra = ROWPERM ? ((R >> 6) * 128 + (R & 15) * 8 + ((R >> 4) & 3)) : R;
        voffA[i] = (unsigned)(Ra * K + C) * 2u; voffB[i] = (unsigned)(Rb * K + C) * 2u; }
    const size_t kstep = (size_t)(BK * 2);
    const size_t hstepB = (size_t)HALF * K * 2;
    const size_t hstepA = ROWPERM ? (size_t)4 * K * 2 : hstepB;
    const size_t tstep = 2 * hstepB;
    const unsigned ldsw = (unsigned)wid * 1024u;
    const int aoff = lds_byte(wr * 64 + fr, fq * 8), boff = lds_byte(wc * 32 + fr, fq * 8);
#define PG8_SA(b, h) (((b) * 2 + (h)) * HTB)
#define PG8_SB(b, h) ((4 + (b) * 2 + (h)) * HTB)
#define PG8_STAGE(bufoff, gbase, voff) do { _Pragma("unroll") for (int _i = 0; _i < 2; ++_i) \
        __builtin_amdgcn_global_load_lds((const unsigned*)((const char*)(gbase) + (voff)[_i]), (PG8_LAS unsigned*)(lds + (bufoff) + ldsw + _i * 8192), 16, 0, 0); } while (0)
#define PG8_LDA(dst, b, h) do { _Pragma("unroll") for (int m = 0; m < 4; ++m) _Pragma("unroll") for (int k = 0; k < 2; ++k) dst[m][k] = *(const PG8_LAS bf16x8*)(lds + PG8_SA(b, h) + aoff + m * 2048 + k * 1024); } while (0)
#define PG8_LDB(dst, b, h) do { _Pragma("unroll") for (int n = 0; n < 2; ++n) _Pragma("unroll") for (int k = 0; k < 2; ++k) dst[n][k] = *(const PG8_LAS bf16x8*)(lds + PG8_SB(b, h) + boff + n * 2048 + k * 1024); } while (0)
#define PG8_MMA(ai, bj, At, Bt) do { __builtin_amdgcn_s_setprio(1); _Pragma("unroll") for (int m = 0; m < 4; ++m) _Pragma("unroll") for (int n = 0; n < 2; ++n) _Pragma("unroll") for (int k = 0; k < 2; ++k) \
        acc[ai][bj][m][n] = __builtin_amdgcn_mfma_f32_16x16x32_bf16(Bt[n][k], At[m][k], acc[ai][bj][m][n], 0, 0, 0); __builtin_amdgcn_s_setprio(0); } while (0)
#define PG8_WAIT_V(n) asm volatile("s_waitcnt vmcnt(" #n ")" ::: "memory")
#define PG8_WAIT_L(n) asm volatile("s_waitcnt lgkmcnt(" #n ")" ::: "memory")
#define PG8_BAR __builtin_amdgcn_s_barrier()
#define PG8_SCHED __builtin_amdgcn_sched_barrier(0)
    Unit cur, nxt; int ui = 0;
    if (!S.next(0, cur)) return;
    f32x4 acc[2][2][4][2];
#pragma unroll
    for (int a = 0; a < 2; ++a)
#pragma unroll
        for (int b = 0; b < 2; ++b)
#pragma unroll
            for (int m = 0; m < 4; ++m)
#pragma unroll
                for (int n = 0; n < 2; ++n) acc[a][b][m][n] = (f32x4){0.f, 0.f, 0.f, 0.f};
    bf16x8 At[4][2], B0[2][2], B1[2][2];
    const char* cA = (const char*)g.A + (size_t)cur.pm * tstep; const char* cB = (const char*)g.Bt + (size_t)cur.pn * tstep;
    S.a_ready(cur);
    if constexpr (SP2) {
        PG8_STAGE(PG8_SB(0, 0), cB, voffB); PG8_STAGE(PG8_SB(0, 1), cB + hstepB, voffB); PG8_STAGE(PG8_SA(0, 0), cA, voffA); PG8_STAGE(PG8_SA(0, 1), cA + hstepA, voffA);
        if (wr == 1) PG8_BAR;
        PG8_WAIT_V(2); PG8_BAR;
        PG8_STAGE(PG8_SB(1, 0), cB + kstep, voffB); PG8_STAGE(PG8_SA(1, 0), cA + kstep, voffA); PG8_STAGE(PG8_SB(1, 1), cB + hstepB + kstep, voffB);
        PG8_WAIT_V(6); PG8_BAR;
    } else {
        PG8_STAGE(PG8_SB(0, 0), cB, voffB); PG8_STAGE(PG8_SA(0, 0), cA, voffA); PG8_STAGE(PG8_SB(0, 1), cB + hstepB, voffB); PG8_STAGE(PG8_SA(0, 1), cA + hstepA, voffA);
        if (wr == 1) PG8_BAR;
        PG8_WAIT_V(4); PG8_BAR;
        PG8_STAGE(PG8_SB(1, 0), cB + kstep, voffB); PG8_STAGE(PG8_SA(1, 0), cA + kstep, voffA); PG8_STAGE(PG8_SB(1, 1), cB + hstepB + kstep, voffB);
        PG8_WAIT_V(6); PG8_BAR;
    }
    for (;;) {
        const bool has_next = S.next(ui + 1, nxt);
        const char* nA = has_next ? (const char*)g.A + (size_t)nxt.pm * tstep : cA; const char* nB = has_next ? (const char*)g.Bt + (size_t)nxt.pn * tstep : cB;
        for (int t = 0; t < nt; t += 2) {
            const bool last = (t == nt - 2);
            const char* a1 = cA + (size_t)(t + 1) * kstep;
            const char* a2 = last ? nA : cA + (size_t)(t + 2) * kstep; const char* b2 = last ? nB : cB + (size_t)(t + 2) * kstep;
            const char* a3 = a2 + kstep; const char* b3 = b2 + kstep;
            if (last && has_next) S.a_ready(nxt);
            if constexpr (SP2) {
            PG8_LDB(B0, 0, 0); PG8_LDB(B1, 0, 1); PG8_SCHED; PG8_LDA(At, 0, 0); PG8_STAGE(PG8_SA(1, 1), a1 + hstepA, voffA);
            PG8_WAIT_V(8); PG8_WAIT_L(0); PG8_BAR; PG8_MMA(0, 0, At, B0); PG8_MMA(0, 1, At, B1); PG8_BAR; PG8_SCHED;
            PG8_LDA(At, 0, 1); PG8_STAGE(PG8_SB(0, 0), b2, voffB); PG8_STAGE(PG8_SB(0, 1), b2 + hstepB, voffB); PG8_STAGE(PG8_SA(0, 0), a2, voffA);
            PG8_WAIT_V(8); PG8_WAIT_L(0); PG8_BAR; PG8_MMA(1, 0, At, B0); PG8_MMA(1, 1, At, B1); PG8_BAR; PG8_SCHED;
            PG8_LDB(B0, 1, 0); PG8_LDB(B1, 1, 1); PG8_SCHED; PG8_LDA(At, 1, 0); PG8_STAGE(PG8_SA(0, 1), a2 + hstepA, voffA);
            PG8_WAIT_V(8); PG8_WAIT_L(0); PG8_BAR; PG8_MMA(0, 0, At, B0); PG8_MMA(0, 1, At, B1); PG8_BAR; PG8_SCHED;
            PG8_LDA(At, 1, 1); PG8_STAGE(PG8_SB(1, 0), b3, voffB); PG8_STAGE(PG8_SB(1, 1), b3 + hstepB, voffB); PG8_STAGE(PG8_SA(1, 0), a3, voffA);
            PG8_WAIT_V(8); PG8_WAIT_L(0); PG8_BAR; PG8_MMA(1, 0, At, B0); PG8_MMA(1, 1, At, B1); PG8_BAR; PG8_SCHED;
            } else {
            PG8_LDB(B0, 0, 0); PG8_SCHED; PG8_LDA(At, 0, 0); PG8_STAGE(PG8_SA(1, 1), a1 + hstepA, voffA);
            PG8_WAIT_L(8); PG8_BAR; PG8_WAIT_L(0); PG8_MMA(0, 0, At, B0); PG8_BAR; PG8_SCHED;
            PG8_LDB(B1, 0, 1); PG8_STAGE(PG8_SB(0, 0), b2, voffB);
            PG8_BAR; PG8_WAIT_L(0); PG8_MMA(0, 1, At, B1); PG8_BAR;
            PG8_LDA(At, 0, 1); PG8_STAGE(PG8_SA(0, 0), a2, voffA);
            PG8_BAR; PG8_WAIT_L(0); PG8_MMA(1, 0, At, B0); PG8_BAR; PG8_SCHED;
            PG8_STAGE(PG8_SB(0, 1), b2 + hstepB, voffB);
            PG8_WAIT_V(6); PG8_BAR; PG8_MMA(1, 1, At, B1); PG8_BAR;
            PG8_LDB(B0, 1, 0); PG8_SCHED; PG8_LDA(At, 1, 0); PG8_STAGE(PG8_SA(0, 1), a2 + hstepA, voffA);
            PG8_WAIT_L(8); PG8_BAR; PG8_WAIT_L(0); PG8_MMA(0, 0, At, B0); PG8_BAR; PG8_SCHED;
            PG8_LDB(B1, 1, 1); PG8_STAGE(PG8_SB(1, 0), b3, voffB);
            PG8_BAR; PG8_WAIT_L(0); PG8_MMA(0, 1, At, B1); PG8_BAR;
            PG8_LDA(At, 1, 1); PG8_STAGE(PG8_SA(1, 0), a3, voffA);
            PG8_BAR; PG8_WAIT_L(0); PG8_MMA(1, 0, At, B0); PG8_BAR; PG8_SCHED;
            PG8_STAGE(PG8_SB(1, 1), b3 + hstepB, voffB);
            PG8_WAIT_V(6); PG8_BAR; PG8_MMA(1, 1, At, B1); PG8_BAR;
            }
        }
        if constexpr (ALIGN_EPI) { if (wr == 0) PG8_BAR; }
        if constexpr (!Epi::AFTER_DRAIN) { E(acc, cur, wr, wc, fr, fq); S.done(cur); }
        if (!has_next) break;
#pragma unroll
        for (int a = 0; a < 2; ++a)
#pragma unroll
            for (int b = 0; b < 2; ++b)
#pragma unroll
                for (int m = 0; m < 4; ++m)
#pragma unroll
                    for (int n = 0; n < 2; ++n) acc[a][b][m][n] = (f32x4){0.f, 0.f, 0.f, 0.f};
        cur = nxt; cA = nA; cB = nB; ++ui;
        if constexpr (ALIGN_EPI) { if (wr == 1) PG8_BAR; }
    }
    PG8_WAIT_V(0);
    if constexpr (!ALIGN_EPI) { if (wr == 0) PG8_BAR; }
    PG8_BAR;
    if constexpr (Epi::AFTER_DRAIN) { E.fused(acc, cur, wr, wc, fr, fq, lds, wid, lane); S.done(cur); }
#undef PG8_SA
#undef PG8_SB
#undef PG8_STAGE
#undef PG8_LDA
#undef PG8_LDB
#undef PG8_MMA
#undef PG8_WAIT_V
#undef PG8_WAIT_L
#undef PG8_BAR
#undef PG8_SCHED
}
}

namespace att {
#define LAS __attribute__((address_space(3)))
typedef unsigned short bf16;
typedef short bf16x8 __attribute__((ext_vector_type(8)));
typedef short s16x4 __attribute__((ext_vector_type(4)));
typedef float f32x16 __attribute__((ext_vector_type(16)));
typedef float f32x4 __attribute__((ext_vector_type(4)));
typedef unsigned u32x4 __attribute__((ext_vector_type(4)));
typedef unsigned u32x2 __attribute__((ext_vector_type(2)));
typedef float f32x2_t __attribute__((ext_vector_type(2)));
typedef __bf16 bf16x2_t __attribute__((ext_vector_type(2)));
typedef short v4i16_t __attribute__((ext_vector_type(4)));
typedef LAS const char* lds_cptr;
constexpr int SEQ = 8192;
constexpr float LOG2E = 1.4426950408889634f;
#define MFMA32(a, b, c) __builtin_amdgcn_mfma_f32_32x32x16_bf16(a, b, c, 0, 0, 0)
__device__ __forceinline__ int crow(int r, int hi) { return (r & 3) + 8 * (r >> 2) + 4 * hi; }
__device__ __forceinline__ unsigned cvtpk(float lo, float hi) { f32x2_t v = {lo, hi}; bf16x2_t b = __builtin_convertvector(v, bf16x2_t); return __builtin_bit_cast(unsigned, b); }
__device__ __forceinline__ void glds16(const void* gsrc, unsigned lds_dst) { unsigned keep;
    asm volatile("s_mov_b32 %0, m0\n\ts_mov_b32 m0, %2\n\ts_nop 0\n\tglobal_load_lds_dwordx4 %1, off\n\ts_mov_b32 m0, %0" : "=&s"(keep) : "v"(gsrc), "s"(lds_dst) : "memory"); }
__device__ __forceinline__ s16x4 vtr(lds_cptr p) { return __builtin_bit_cast(s16x4, __builtin_amdgcn_ds_read_tr16_b64_v4i16((LAS v4i16_t*)p)); }
__device__ __forceinline__ bf16x8 kfrag(lds_cptr p) { return *(const LAS bf16x8*)p; }
#define MX3(a, b, c) __builtin_fmaxf(__builtin_fmaxf((a), (b)), (c))
__device__ __forceinline__ float half_swap_max(float m) { auto rr = __builtin_amdgcn_permlane32_swap(__float_as_uint(m), __float_as_uint(m), false, false); return __builtin_fmaxf(__uint_as_float(rr[0]), __uint_as_float(rr[1])); }
__device__ __forceinline__ float half_swap_sum(float m) { auto rr = __builtin_amdgcn_permlane32_swap(__float_as_uint(m), __float_as_uint(m), false, false); return __uint_as_float(rr[0]) + __uint_as_float(rr[1]); }
__device__ __forceinline__ float rowmax2(const f32x16& p0, const f32x16& p1) {
    float a = MX3(p0[0], p0[1], p1[0]), b = MX3(p0[2], p0[3], p1[1]); a = MX3(a, p1[2], p1[3]);
#pragma unroll
    for (int r = 4; r < 16; r += 4) { a = MX3(a, p0[r], p0[r + 1]); b = MX3(b, p0[r + 2], p0[r + 3]); a = MX3(a, p1[r], p1[r + 1]); b = MX3(b, p1[r + 2], p1[r + 3]); }
    return half_swap_max(__builtin_fmaxf(a, b)); }
#define WAIT_BAR(N) asm volatile("s_waitcnt vmcnt(" #N ") lgkmcnt(0)\n\ts_barrier" ::: "memory")
#define PKF(P, i) cvtpk(P[i], P[i + 1])

constexpr int DK_SLOT = 8192, DV_SLOT = 16384, D_LDS_K = 0, D_LDS_V = 3 * DK_SLOT;
template <int THRL>
__device__ __forceinline__ void diff_pass(int b, int h, int m, int qb, const bf16* QB, const bf16* KB, const bf16* VB, char* shm, f32x16 (&o)[4], float& l_out) {
    int tid_ = threadIdx.x; asm volatile("" : "+v"(tid_));
    const int tid = tid_, lane = tid & 63, r32 = lane & 31, hi = lane >> 5; const int wid = __builtin_amdgcn_readfirstlane(tid >> 6);
    const long rowbase = (long)b * SEQ; const int q0 = qb * 256;
    const bf16* Qw = QB + (rowbase + q0 + wid * 32) * 512 + h * 128 + m * 64;
    const char* Kt = (const char*)KB + ((size_t)((b * 4 + h) * 2 + m) * 128) * 8192 + wid * 1024 + lane * 16;
    const char* Vt = (const char*)VB + ((size_t)(b * 4 + h) * 128) * 16384 + wid * 1024 + lane * 16;
    const unsigned lds0 = (unsigned)(uintptr_t)shm;
    const unsigned kdst = lds0 + D_LDS_K + wid * 1024, vdst = lds0 + D_LDS_V + wid * 1024;
#define DMA_T(t, s) do { glds16(Kt + (size_t)(t) * 8192, (unsigned)__builtin_amdgcn_readfirstlane(kdst + (s) * DK_SLOT)); \
        glds16(Vt + (size_t)(t) * 16384, (unsigned)__builtin_amdgcn_readfirstlane(vdst + (s) * DV_SLOT)); \
        glds16(Vt + (size_t)(t) * 16384 + 8192, (unsigned)__builtin_amdgcn_readfirstlane(vdst + (s) * DV_SLOT + 8192)); } while (0)
    const lds_cptr shm3 = (lds_cptr)shm;
    const lds_cptr kp0 = shm3 + D_LDS_K + hi * 1024 + r32 * 16;
    const lds_cptr vp0 = shm3 + D_LDS_V + ((lane >> 4) & 1) * 32 + (lane & 3) * 8 + (4 * hi + ((lane & 15) >> 2)) * 64;
    const int NT = 4 * (qb + 1);
    DMA_T(0, 0); DMA_T(1, 1);
    bf16x8 qr[4];
#pragma unroll
    for (int d0 = 0; d0 < 4; ++d0) qr[d0] = *reinterpret_cast<const bf16x8*>(&Qw[(long)r32 * 512 + d0 * 16 + hi * 8]);
    const float beta = LOG2E * __builtin_amdgcn_exp2f(-(float)(5 + h));
    const float B64 = 64.f * beta, W32 = __builtin_amdgcn_exp2f(32.f * beta), Whi = hi ? __builtin_amdgcn_exp2f(4.f * beta) : 1.f;
    float Wr[16];
#pragma unroll
    for (int r = 0; r < 16; ++r) Wr[r] = __uint_as_float(__builtin_amdgcn_readfirstlane(__float_as_uint(__builtin_amdgcn_exp2f(beta * (float)((r & 3) + 8 * (r >> 2))))));
#pragma unroll
    for (int d = 0; d < 4; ++d) o[d] = f32x16{};
    float nm = 0.f, l_reg = 0.f;
    const int qrel = wid * 32 + r32;
    int slot = 0, slot2 = 2;
#pragma unroll 1
    for (int t = 0; t < NT; ++t) {
        if (t + 1 < NT) WAIT_BAR(3); else WAIT_BAR(0);
        if (t + 2 < NT) DMA_T(t + 2, slot2);
        f32x16 ci;
#pragma unroll
        for (int r = 0; r < 16; ++r) ci[r] = nm;
        f32x16 p0, p1;
        const lds_cptr kp = kp0 + slot * DK_SLOT;
        p0 = MFMA32(kfrag(kp), qr[0], ci); p1 = MFMA32(kfrag(kp + 512), qr[0], ci);
#pragma unroll
        for (int d0 = 1; d0 < 4; ++d0) { p0 = MFMA32(kfrag(kp + d0 * 2048), qr[d0], p0); p1 = MFMA32(kfrag(kp + d0 * 2048 + 512), qr[d0], p1); }
        const int jb = t - (NT - 4);
        if (jb >= 0) {
            const int kb = 64 * jb + 4 * hi;
#pragma unroll
            for (int r = 0; r < 16; ++r) { const int kv = kb + (r & 3) + 8 * (r >> 2); if (kv > qrel) p0[r] = -INFINITY; if (kv + 32 > qrel) p1[r] = -INFINITY; }
        }
        const float rm = rowmax2(p0, p1);
        const float dl = (t == 0) ? rm : ((rm > (float)THRL) ? rm : 0.f);
        const float f = (t == 0) ? 1.f : __builtin_amdgcn_exp2f(-dl);
        nm -= dl; l_reg *= f;
#pragma unroll
        for (int r = 0; r < 16; ++r) { p0[r] -= dl; p1[r] -= dl; }
        if (__any(f != 1.f)) {
#pragma unroll
            for (int d = 0; d < 4; ++d)
#pragma unroll
                for (int r = 0; r < 16; ++r) o[d][r] *= f;
        }
        float s0 = 0.f, s1 = 0.f;
#pragma unroll
        for (int r = 0; r < 16; ++r) { p0[r] = __builtin_amdgcn_exp2f(p0[r]); p1[r] = __builtin_amdgcn_exp2f(p1[r]); s0 = __builtin_fmaf(p0[r], Wr[r], s0); s1 = __builtin_fmaf(p1[r], Wr[r], s1); }
        l_reg += Whi * (s0 + W32 * s1);
        u32x4 pw[4];
        pw[0] = (u32x4){PKF(p0, 0), PKF(p0, 2), PKF(p0, 4), PKF(p0, 6)}; pw[1] = (u32x4){PKF(p0, 8), PKF(p0, 10), PKF(p0, 12), PKF(p0, 14)};
        pw[2] = (u32x4){PKF(p1, 0), PKF(p1, 2), PKF(p1, 4), PKF(p1, 6)}; pw[3] = (u32x4){PKF(p1, 8), PKF(p1, 10), PKF(p1, 12), PKF(p1, 14)};
        const lds_cptr vp = vp0 + slot * DV_SLOT;
#pragma unroll
        for (int d0 = 0; d0 < 4; ++d0) {
#pragma unroll
            for (int ks = 0; ks < 4; ++ks) {
                const s16x4 lo = vtr(vp + d0 * 4096 + ks * 1024), hv = vtr(vp + d0 * 4096 + ks * 1024 + 512);
                const bf16x8 vf = (bf16x8){lo[0], lo[1], lo[2], lo[3], hv[0], hv[1], hv[2], hv[3]};
                o[d0] = MFMA32(vf, __builtin_bit_cast(bf16x8, pw[ks]), o[d0]);
            }
            __builtin_amdgcn_sched_barrier(0);
        }
        nm += B64;
        slot = (slot == 2) ? 0 : slot + 1; slot2 = (slot2 == 2) ? 0 : slot2 + 1;
    }
    l_out = half_swap_sum(l_reg);
    WAIT_BAR(0);
#undef DMA_T
}

__device__ __forceinline__ void diff_unit(int b, int h, int qb, const bf16* QB, const bf16* KB, const bf16* VB, bf16* MIX, float* stash, float lam, const float* subg, char* shm) {
    int tid_ = threadIdx.x; asm volatile("" : "+v"(tid_));
    const int tid = tid_, lane = tid & 63, r32 = lane & 31, hi = lane >> 5; const int wid = __builtin_amdgcn_readfirstlane(tid >> 6);
    f32x16 o[4]; float l;
#pragma unroll 1
    for (int m = 0; m < 2; ++m) {
        diff_pass<6>(b, h, m, qb, QB, KB, VB, shm, o, l);
        if (m == 0) {
            const float rl = __builtin_amdgcn_rcpf(l);
            f32x4* st = (f32x4*)stash + tid * 16;
#pragma unroll
            for (int d = 0; d < 4; ++d)
#pragma unroll
                for (int g = 0; g < 4; ++g) st[d * 4 + g] = (f32x4){o[d][4 * g] * rl, o[d][4 * g + 1] * rl, o[d][4 * g + 2] * rl, o[d][4 * g + 3] * rl};
        } else {
            const float rl = lam * __builtin_amdgcn_rcpf(l);
            const f32x4* st = (const f32x4*)stash + tid * 16; float ss = 0.f;
#pragma unroll
            for (int d = 0; d < 4; ++d)
#pragma unroll
                for (int g = 0; g < 4; ++g) { const f32x4 a = st[d * 4 + g];
#pragma unroll
                    for (int e = 0; e < 4; ++e) { const float v = a[e] - o[d][4 * g + e] * rl; o[d][4 * g + e] = v; ss = __builtin_fmaf(v, v, ss); } }
            ss = half_swap_sum(ss);
            const float rs = 0.8f * __builtin_amdgcn_rsqf(ss * (1.0f / 128.0f) + 1e-6f);
            bf16* orow = MIX + ((long)b * SEQ + qb * 256 + wid * 32 + r32) * 1024 + 512 + h * 128 + 4 * hi;
#pragma unroll
            for (int d = 0; d < 4; ++d)
#pragma unroll
                for (int g = 0; g < 4; ++g) { const f32x4 gg = *(const f32x4*)(subg + 32 * d + 8 * g + 4 * hi);
                    u32x2 w; w.x = cvtpk(o[d][4 * g] * rs * gg[0], o[d][4 * g + 1] * rs * gg[1]); w.y = cvtpk(o[d][4 * g + 2] * rs * gg[2], o[d][4 * g + 3] * rs * gg[3]);
                    *(u32x2*)(orow + 32 * d + 8 * g) = w; }
        }
    }
}

__device__ __forceinline__ void swa_unit(int b, int nb, const bf16* QA, const bf16* KA, const bf16* VA, bf16* MIX, const float* sinks, const float* gain, char* shm, int ss_off) {
    int tid_ = threadIdx.x; asm volatile("" : "+v"(tid_));
    const int tid = tid_, lane = tid & 63, r32 = lane & 31, hi = lane >> 5; const int wid = __builtin_amdgcn_readfirstlane(tid >> 6);
    const long t0 = (long)b * SEQ + nb * 128;
    LAS char* sh = (LAS char*)shm;
#pragma unroll 4
    for (int i = 0; i < 16; ++i) {
        const int p = i * 512 + tid, kvh = p >> 12, rem = p & 4095, isV = rem >> 11, r2 = rem & 2047, key = r2 >> 3, c = r2 & 7;
        const bool valid = (nb > 0) || key >= 128;
        const bf16* src = (isV ? VA : KA) + (t0 - 128 + key) * 128 + kvh * 64 + c * 8;
        u32x4 v = (u32x4){0u, 0u, 0u, 0u}; if (valid) v = *(const u32x4*)src;
        const int dst = isV ? (65536 + kvh * 32768 + (c >> 2) * 16384 + (key >> 4) * 1024 + (key & 15) * 64 + (c & 3) * 16) : (kvh * 32768 + c * 4096 + key * 16);
        *(LAS u32x4*)(sh + dst) = v;
    }
    __syncthreads();
    const int hq = wid, kvh = wid >> 2;
    const float slope2 = LOG2E * __builtin_amdgcn_exp2f(-0.5f * (float)(hq + 1)), sink2 = sinks[hq] * LOG2E;
    const lds_cptr Kf = (lds_cptr)shm + kvh * 32768 + hi * 4096 + r32 * 16;
    const lds_cptr Vf = (lds_cptr)shm + 65536 + kvh * 32768 + ((lane >> 4) & 1) * 32 + (lane & 3) * 8 + (4 * hi + ((lane & 15) >> 2)) * 64;
    LAS float* SS = (LAS float*)(sh + ss_off);
    for (int i = 0; i < 4; ++i) {
        const bf16* Qw = QA + (t0 + 32 * i + r32) * 512 + hq * 64 + hi * 8;
        bf16x8 qr[4];
#pragma unroll
        for (int d0 = 0; d0 < 4; ++d0) qr[d0] = *reinterpret_cast<const bf16x8*>(Qw + d0 * 16);
        f32x16 s[5];
#pragma unroll
        for (int c5 = 0; c5 < 5; ++c5) {
            const int ch = i + c5; const lds_cptr kp = Kf + ch * 512;
            f32x16 a = f32x16{};
#pragma unroll
            for (int d0 = 0; d0 < 4; ++d0) a = MFMA32(kfrag(kp + d0 * 8192), qr[d0], a);
            const int base = 128 + 32 * i + r32 - 32 * ch - 4 * hi;
#pragma unroll
            for (int r = 0; r < 16; ++r) { const int dist = base - ((r & 3) + 8 * (r >> 2)); const int fk = 32 * ch + 4 * hi + (r & 3) + 8 * (r >> 2);
                const bool ok = dist >= 0 && dist < 128 && (nb > 0 || fk >= 128);
                a[r] = ok ? a[r] - slope2 * (float)dist : -INFINITY; }
            s[c5] = a;
        }
        float mx = sink2;
#pragma unroll
        for (int c5 = 0; c5 < 5; ++c5)
#pragma unroll
            for (int r = 0; r < 16; r += 2) mx = MX3(mx, s[c5][r], s[c5][r + 1]);
        mx = half_swap_max(mx);
        float ls = 0.f;
#pragma unroll
        for (int c5 = 0; c5 < 5; ++c5)
#pragma unroll
            for (int r = 0; r < 16; ++r) { s[c5][r] = __builtin_amdgcn_exp2f(s[c5][r] - mx); ls += s[c5][r]; }
        ls = half_swap_sum(ls) + __builtin_amdgcn_exp2f(sink2 - mx);
        f32x16 o[2]; o[0] = f32x16{}; o[1] = f32x16{};
#pragma unroll
        for (int c5 = 0; c5 < 5; ++c5)
#pragma unroll
            for (int k2 = 0; k2 < 2; ++k2) {
                const u32x4 pw = (u32x4){PKF(s[c5], 8 * k2), PKF(s[c5], 8 * k2 + 2), PKF(s[c5], 8 * k2 + 4), PKF(s[c5], 8 * k2 + 6)};
                const int kg = 2 * (i + c5) + k2;
#pragma unroll
                for (int d0 = 0; d0 < 2; ++d0) {
                    const s16x4 lo = vtr(Vf + d0 * 16384 + kg * 1024), hv = vtr(Vf + d0 * 16384 + kg * 1024 + 512);
                    const bf16x8 vf = (bf16x8){lo[0], lo[1], lo[2], lo[3], hv[0], hv[1], hv[2], hv[3]};
                    o[d0] = MFMA32(vf, __builtin_bit_cast(bf16x8, pw), o[d0]);
                }
            }
        const float rl = __builtin_amdgcn_rcpf(ls); float ss = 0.f;
        bf16* orow = MIX + (t0 + 32 * i + r32) * 1024 + hq * 64 + 4 * hi;
#pragma unroll
        for (int d0 = 0; d0 < 2; ++d0)
#pragma unroll
            for (int g = 0; g < 4; ++g) {
                const float y0 = o[d0][4 * g] * rl, y1 = o[d0][4 * g + 1] * rl, y2 = o[d0][4 * g + 2] * rl, y3 = o[d0][4 * g + 3] * rl;
                ss += (y0 * y0 + y1 * y1) + (y2 * y2 + y3 * y3);
                u32x2 w; w.x = cvtpk(y0, y1); w.y = cvtpk(y2, y3); *(u32x2*)(orow + 32 * d0 + 8 * g) = w; }
        ss = half_swap_sum(ss);
        if (hi == 0) SS[(32 * i + r32) * 8 + hq] = ss;
    }
    __syncthreads();
#pragma unroll 4
    for (int i = 0; i < 16; ++i) {
        const int idx = i * 512 + tid, row = idx >> 6, chn = idx & 63;
        const f32x4 sa = *(const LAS f32x4*)(SS + row * 8), sb = *(const LAS f32x4*)(SS + row * 8 + 4);
        const float tot = (sa[0] + sa[1]) + (sa[2] + sa[3]) + (sb[0] + sb[1]) + (sb[2] + sb[3]);
        const float rr = __builtin_amdgcn_rsqf(tot * (1.0f / 512.0f) + 1e-6f);
        u32x4* pp = (u32x4*)(MIX + (t0 + row) * 1024 + chn * 8); const u32x4 v = *pp;
        const f32x4 g0 = *(const f32x4*)(gain + chn * 8), g1 = *(const f32x4*)(gain + chn * 8 + 4);
        u32x4 w;
        w.x = cvtpk(__uint_as_float(v.x << 16) * rr * g0[0], __uint_as_float(v.x & 0xffff0000u) * rr * g0[1]);
        w.y = cvtpk(__uint_as_float(v.y << 16) * rr * g0[2], __uint_as_float(v.y & 0xffff0000u) * rr * g0[3]);
        w.z = cvtpk(__uint_as_float(v.z << 16) * rr * g1[0], __uint_as_float(v.z & 0xffff0000u) * rr * g1[1]);
        w.w = cvtpk(__uint_as_float(v.w << 16) * rr * g1[2], __uint_as_float(v.w & 0xffff0000u) * rr * g1[3]);
        *pp = w;
    }
    __syncthreads();
}
#undef WAIT_BAR
#undef PKF
#undef MX3
#undef MFMA32
}

constexpr int NWAVES = 8;
constexpr int BATCH = 4, SEQ = 8192, DM = 1024, MTOK = BATCH * SEQ;
constexpr int NPROJ = 2304, DFF = 4096, NUP = 2 * DFF;
constexpr float EPS = 1e-6f, LOG2E_F = 1.4426950408889634f, QSCALE = 0.125f * 1.4426950408889634f;
constexpr size_t MiB = 1u << 20;
constexpr size_t WS_CTL = 0, WS_WIN = 1 * MiB, WS_WOUT = 6 * MiB, WS_WUP = 8 * MiB, WS_WDN = 24 * MiB, WS_XN = 32 * MiB;
constexpr size_t WS_QA = 96 * MiB, WS_KA = 128 * MiB, WS_VA = 136 * MiB, WS_QB = 144 * MiB, WS_KB = 176 * MiB, WS_VB = 208 * MiB, WS_MIX = 240 * MiB, WS_STASH = 304 * MiB;
constexpr size_t WS_ORAW = 96 * MiB, WS_ACT = 96 * MiB, WS_UB = 352 * MiB, WS_FRAW = 384 * MiB, WS_END = 448 * MiB;
constexpr int RING_BYTES = 131072, SS_OFF = RING_BYTES, LDS_BYTES = 147456;

#define GAS __attribute__((address_space(1)))
typedef unsigned short bf16;
typedef unsigned v4u __attribute__((ext_vector_type(4)));
typedef unsigned v2u __attribute__((ext_vector_type(2)));
typedef float f32x4 __attribute__((ext_vector_type(4)));
#define LDS_WAIT() asm volatile("s_waitcnt lgkmcnt(0)" ::: "memory")
__device__ __forceinline__ unsigned f2bf(float f) { unsigned u = __builtin_bit_cast(unsigned, f); return (u + 0x7fffu + ((u >> 16) & 1u)) >> 16; }
__device__ __forceinline__ unsigned pk2(float lo, float hi) { return f2bf(lo) | (f2bf(hi) << 16); }
__device__ __forceinline__ float bflo(unsigned w) { return __uint_as_float(w << 16); }
__device__ __forceinline__ float bfhi(unsigned w) { return __uint_as_float(w & 0xffff0000u); }
__device__ __forceinline__ float wave_sum(float v) {
#pragma unroll
    for (int o = 1; o < 64; o <<= 1) v += __shfl_xor(v, o);
    return v;
}
template <int MODE>
__device__ __forceinline__ void p0_transpose_item(const float* W, int K, int N, bf16* WT, const float* gain, LAS float* scr, int item, int lane) {
    const int nblk = N / 32, kb = item / nblk, nb = item % nblk, k0 = 64 * kb, n0 = 32 * nb;
#pragma unroll 8
    for (int i = 0; i < 32; ++i) { const int kk = 2 * i + (lane >> 5); float w = W[(size_t)(k0 + kk) * N + n0 + (lane & 31)]; if (MODE != 0) w *= gain[k0 + kk]; scr[kk * 33 + (lane & 31)] = w; }
    LDS_WAIT(); asm volatile("" ::: "memory");
    float cs = 1.f; if (MODE == 1) { if (n0 < 512 || (n0 >= 768 && n0 < 1280)) cs = QSCALE; }
    int r0 = n0; if (MODE == 2) { const int f = n0 & 4095; r0 = (f >> 7) * 256 + ((n0 >= 4096) ? 128 : 0) + (f & 127); }
    const int c = lane & 7;
#pragma unroll
    for (int j = 0; j < 4; ++j) { const int n = (lane >> 3) + 8 * j; const LAS float* s = scr + (8 * c) * 33 + n;
        v4u o; o.x = pk2(s[0 * 33] * cs, s[1 * 33] * cs); o.y = pk2(s[2 * 33] * cs, s[3 * 33] * cs); o.z = pk2(s[4 * 33] * cs, s[5 * 33] * cs); o.w = pk2(s[6 * 33] * cs, s[7 * 33] * cs);
        *(GAS v4u*)(WT + (size_t)(r0 + n) * K + k0 + 8 * c) = o; }
    LDS_WAIT(); asm volatile("" ::: "memory");
}
__device__ __forceinline__ void rms_row_to_bf16(const float* xrow, bf16* orow, int lane) {
    const GAS f32x4* xr = (const GAS f32x4*)xrow + lane;
    f32x4 v[4]; float s = 0.f;
#pragma unroll
    for (int j = 0; j < 4; ++j) { v[j] = xr[64 * j]; s += (v[j].x * v[j].x + v[j].y * v[j].y) + (v[j].z * v[j].z + v[j].w * v[j].w); }
    const float r = 1.0f / sqrtf(wave_sum(s) * (1.f / DM) + EPS);
    GAS v2u* o8 = (GAS v2u*)orow + lane;
#pragma unroll
    for (int j = 0; j < 4; ++j) { v2u w; w.x = pk2(v[j].x * r, v[j].y * r); w.y = pk2(v[j].z * r, v[j].w * r); o8[64 * j] = w; }
}
template <bool WITH_XN>
__device__ __forceinline__ void post_row(const bf16* raw, const float* base, const float* g, float* out, bf16* xn, int lane) {
    const GAS v2u* rr = (const GAS v2u*)raw + lane; const GAS f32x4* br = (const GAS f32x4*)base + lane; const GAS f32x4* gr = (const GAS f32x4*)g + lane;
    f32x4 o[4], xb[4]; float s = 0.f;
#pragma unroll
    for (int j = 0; j < 4; ++j) { const v2u w = rr[64 * j]; o[j] = (f32x4){bflo(w.x), bfhi(w.x), bflo(w.y), bfhi(w.y)}; xb[j] = br[64 * j]; s += (o[j].x * o[j].x + o[j].y * o[j].y) + (o[j].z * o[j].z + o[j].w * o[j].w); }
    const float r = 1.0f / sqrtf(wave_sum(s) * (1.f / DM) + EPS);
    float s2 = 0.f; GAS f32x4* orow = (GAS f32x4*)out + lane;
#pragma unroll
    for (int j = 0; j < 4; ++j) { const f32x4 gg = gr[64 * j]; xb[j] = xb[j] + o[j] * r * gg; orow[64 * j] = xb[j]; s2 += (xb[j].x * xb[j].x + xb[j].y * xb[j].y) + (xb[j].z * xb[j].z + xb[j].w * xb[j].w); }
    if (WITH_XN) {
        const float r2 = 1.0f / sqrtf(wave_sum(s2) * (1.f / DM) + EPS);
        GAS v2u* o8 = (GAS v2u*)xn + lane;
#pragma unroll
        for (int j = 0; j < 4; ++j) { v2u w; w.x = pk2(xb[j].x * r2, xb[j].y * r2); w.y = pk2(xb[j].z * r2, xb[j].w * r2); o8[64 * j] = w; }
    }
}

#ifndef PHASE_MASK
#define PHASE_MASK 0x1ff
#endif
#ifndef REPEAT_MASK
#define REPEAT_MASK 0
#endif
#define REP(k) for (int rep_ = 0; rep_ <= ((REPEAT_MASK >> (k)) & 1); ++rep_)
#define PH(k) if ((PHASE_MASK >> (k)) & 1) REP(k)
#define XB_TMO      128
#define XB_XCNT(j)  (256  + 64 * (j))
#define XB_XSUB(j)  (1280 + 64 * (j))
#define XB_XGEN(j)  (2304 + 64 * (j))
#define XB_TOP      3328
#define XB_TOPGEN   3392
#define XCD_BAR_WORDS 3456
#define XB_SPIN_CAP (1u << 18)

__device__ __forceinline__ unsigned xb_ld(unsigned* p)              { return __hip_atomic_load(p, __ATOMIC_RELAXED, __HIP_MEMORY_SCOPE_AGENT); }
__device__ __forceinline__ unsigned xb_add(unsigned* p, unsigned v) { return __hip_atomic_fetch_add(p, v, __ATOMIC_RELAXED, __HIP_MEMORY_SCOPE_AGENT); }
__device__ __forceinline__ unsigned xb_xcc_id() { return (unsigned)__builtin_amdgcn_s_getreg((3 << 11) | 20) & 0xFu; }
#define XB_SPIN(cond, bar) do { unsigned _sp = 0; while (cond) { __builtin_amdgcn_s_sleep(1); \
    if ((++_sp & 255u) == 0u) { if (xb_ld(&(bar)[XB_TMO])) break; if (_sp > XB_SPIN_CAP) { atomicAdd(&(bar)[XB_TMO], 1u); break; } } } } while (0)

struct XcdBarrier {
    unsigned* bar; unsigned x;
    volatile LAS unsigned* st;
};

__device__ __forceinline__ XcdBarrier xcd_barrier_post(unsigned* bar, volatile LAS unsigned* st) {
    XcdBarrier b; b.bar = bar; b.x = xb_xcc_id(); b.st = st;
    if (threadIdx.x == 0) (void)xb_add(&bar[XB_XCNT(b.x)], 1u);
    return b;
}
__device__ __forceinline__ void xcd_barrier_complete(unsigned* bar, unsigned x, unsigned& nloc, unsigned& nx) {
    const unsigned G = gridDim.x * gridDim.y * gridDim.z;
    unsigned sum, cnt, mine, sp = 0u;
    for (;;) {
        sum = 0u; cnt = 0u; mine = 0u;
#pragma unroll
        for (unsigned j = 0; j < 16; ++j) { const unsigned c = xb_ld(&bar[XB_XCNT(j)]); sum += c; cnt += (c > 0u) ? 1u : 0u; mine = (j == x) ? c : mine; }
        if (sum == G) break;
        __builtin_amdgcn_s_sleep(1);
        if ((++sp & 255u) == 0u) { if (xb_ld(&bar[XB_TMO])) break; if (sp > XB_SPIN_CAP) { atomicAdd(&bar[XB_TMO], 1u); break; } }
    }
    nloc = mine > 0u ? mine : 1u; nx = cnt > 0u ? cnt : 1u;
}

__device__ __forceinline__ void xcd_barrier(const XcdBarrier& b) {
    asm volatile("s_waitcnt vmcnt(0)" ::: "memory");
    __syncthreads();
    if (threadIdx.x == 0) {
        unsigned* bar = b.bar;
        __builtin_amdgcn_s_waitcnt(0);
        unsigned nloc = b.st[0], nx = b.st[1];
        if (nloc == 0u) { xcd_barrier_complete(bar, b.x, nloc, nx); b.st[0] = nloc; b.st[1] = nx; }
        const unsigned old = xb_add(&bar[XB_XSUB(b.x)], 1u);
        const unsigned gen = old / nloc;
        if (old + 1u == (gen + 1u) * nloc) {
            __builtin_amdgcn_fence(__ATOMIC_RELEASE, "agent");
            asm volatile("s_waitcnt vmcnt(0)" ::: "memory");
            const unsigned og = xb_add(&bar[XB_TOP], 1u);
            const unsigned tg = og / nx;
            if (og + 1u == (tg + 1u) * nx) xb_add(&bar[XB_TOPGEN], 1u);
            else XB_SPIN(xb_ld(&bar[XB_TOPGEN]) == tg, bar);
            __builtin_amdgcn_fence(__ATOMIC_ACQUIRE, "agent");
            xb_add(&bar[XB_XGEN(b.x)], 1u);
            asm volatile("s_waitcnt vmcnt(0)" ::: "memory");
        } else {
            XB_SPIN(xb_ld(&bar[XB_XGEN(b.x)]) == gen, bar);
            __builtin_amdgcn_fence(__ATOMIC_ACQUIRE, "agent");
            asm volatile("s_waitcnt vmcnt(0)" ::: "memory");
        }
    }
    __syncthreads();
}

constexpr int MISC_OFF = RING_BYTES + 4096;
#define GRID_BAR() do { XcdBarrier b_; b_.bar = (unsigned*)(args.ws + WS_CTL); b_.x = xb_xcc_id(); b_.st = (volatile LAS unsigned*)((LAS unsigned char*)lds + MISC_OFF) + 8; xcd_barrier(b_); } while (0)
#define PHASE_LOCALS \
    int tid = threadIdx.x; asm volatile("" : "+v"(tid)); \
    const int lane = tid & 63, wave = __builtin_amdgcn_readfirstlane(tid >> 6); \
    int G = gridDim.x, bx = blockIdx.x; asm volatile("" : "+s"(G), "+s"(bx)); \
    const int vcu = (G % 8 == 0) ? (bx % 8) * (G / 8) + bx / 8 : bx; \
    unsigned char* ws = args.ws; asm volatile("" : "+s"(ws)); \
    const float* x = args.in[0]; \
    bf16* Wt_in = (bf16*)(ws + WS_WIN); bf16* Wt_out = (bf16*)(ws + WS_WOUT); bf16* Wt_up = (bf16*)(ws + WS_WUP); bf16* Wt_dn = (bf16*)(ws + WS_WDN); \
    bf16* XN = (bf16*)(ws + WS_XN); \
    bf16* QA = (bf16*)(ws + WS_QA); bf16* KA = (bf16*)(ws + WS_KA); bf16* VA = (bf16*)(ws + WS_VA); \
    bf16* QB = (bf16*)(ws + WS_QB); bf16* KB = (bf16*)(ws + WS_KB); bf16* VB = (bf16*)(ws + WS_VB); \
    bf16* MIX = (bf16*)(ws + WS_MIX); float* STASH = (float*)(ws + WS_STASH); \
    bf16* ORAW = (bf16*)(ws + WS_ORAW); bf16* ACT = (bf16*)(ws + WS_ACT); float* UB = (float*)(ws + WS_UB); bf16* FRAW = (bf16*)(ws + WS_FRAW); \
    LAS unsigned char* ldsl = (LAS unsigned char*)lds; \
    const int gw = vcu * NWAVES + wave, NGW = G * NWAVES; \
    (void)lane; (void)x; (void)Wt_in; (void)Wt_out; (void)Wt_up; (void)Wt_dn; (void)XN; (void)QA; (void)KA; (void)VA; (void)QB; (void)KB; (void)VB; (void)MIX; (void)STASH; (void)ORAW; (void)ACT; (void)UB; (void)FRAW; (void)ldsl; (void)gw; (void)NGW;
struct Args { const float* in[18]; float* out; unsigned char* ws; };

__global__ void __launch_bounds__(NWAVES * 64, 2) hymba_fwd(Args args) {
    extern __shared__ __attribute__((aligned(16))) unsigned char lds[];
    { volatile LAS unsigned* misc = (volatile LAS unsigned*)((LAS unsigned char*)lds + MISC_OFF); if (threadIdx.x < 32) misc[threadIdx.x] = 0u; __syncthreads();
      (void)xcd_barrier_post((unsigned*)(args.ws + WS_CTL), misc + 8); }
    PH(0) { PHASE_LOCALS
        LAS float* scr = (LAS float*)(ldsl + wave * 16384);
        constexpr int I_IN = (DM / 64) * (NPROJ / 32), I_OUT = (DM / 64) * (DM / 32), I_UP = (DM / 64) * (NUP / 32), I_DN = (DFF / 64) * (DM / 32);
        constexpr int NITEMS = I_IN + I_OUT + I_UP + I_DN;
        for (int it = gw; it < NITEMS; it += NGW) {
            int r = it;
            if (r < I_IN) { p0_transpose_item<1>(args.in[2], DM, NPROJ, Wt_in, args.in[1], scr, r, lane); continue; } r -= I_IN;
            if (r < I_OUT) { p0_transpose_item<0>(args.in[10], DM, DM, Wt_out, nullptr, scr, r, lane); continue; } r -= I_OUT;
            if (r < I_UP) { p0_transpose_item<2>(args.in[13], DM, NUP, Wt_up, args.in[12], scr, r, lane); continue; } r -= I_UP;
            p0_transpose_item<0>(args.in[16], DFF, DM, Wt_dn, nullptr, scr, r, lane);
        }
        for (int m = gw; m < MTOK; m += NGW) rms_row_to_bf16(x + (size_t)m * DM, XN + (size_t)m * DM, lane);
    }
    GRID_BAR();

    PH(1) { PHASE_LOCALS
        pg8::Gemm g{XN, Wt_in, MTOK, NPROJ, DM}; pg8::StaticOrder S; S.init(MTOK, NPROJ, G, bx);
        pg8::EpiProj E{QA, KA, VA, QB, KB, VB};
        pg8::gemm_phase<pg8::EpiProj, pg8::StaticOrder, true, true>(ldsl, g, S, E);
    }
    GRID_BAR();

    PH(2) { PHASE_LOCALS
        const float d1 = wave_sum(args.in[5][lane] * args.in[6][lane]), d2 = wave_sum(args.in[7][lane] * args.in[8][lane]);
        const float lam = __expf(d1) - __expf(d2) + 0.2f;
#ifndef ATT_NO_SWA
        REP(9) for (int u = vcu; u < BATCH * (SEQ / 128); u += G)
            att::swa_unit(u / (SEQ / 128), u % (SEQ / 128), QA, KA, VA, MIX, args.in[3], args.in[4], (char*)lds, SS_OFF);
#endif
#ifndef ATT_NO_DIFF
        for (int v = vcu; v < 256; v += G) {
            const int bh = v >> 4, s = v & 15;
            att::diff_unit(bh >> 2, bh & 3, s, QB, KB, VB, MIX, STASH + (size_t)bx * 32768, lam, args.in[9], (char*)lds);
            att::diff_unit(bh >> 2, bh & 3, 31 - s, QB, KB, VB, MIX, STASH + (size_t)bx * 32768, lam, args.in[9], (char*)lds);
        }
#endif
    }
    GRID_BAR();

    PH(3) { PHASE_LOCALS
        pg8::Gemm g{MIX, Wt_out, MTOK, DM, DM}; pg8::StaticOrder S; S.init(MTOK, DM, G, bx);
        pg8::EpiBf16<0> E{ORAW, DM, nullptr, 0, 0, 1.f};
        pg8::gemm_phase<pg8::EpiBf16<0>, pg8::StaticOrder, true, true>(ldsl, g, S, E);
    }
    GRID_BAR();
    PH(4) { PHASE_LOCALS
        for (int m = gw; m < MTOK; m += NGW) post_row<true>(ORAW + (size_t)m * DM, x + (size_t)m * DM, args.in[11], args.out + (size_t)m * DM, XN + (size_t)m * DM, lane); }
    GRID_BAR();

    PH(5) { PHASE_LOCALS
        pg8::Gemm g{XN, Wt_up, MTOK, NUP, DM}; pg8::StaticOrder S; S.init(MTOK, NUP, G, bx);
        pg8::EpiConv E{ACT, UB, args.in[14], args.in[15]};
        pg8::gemm_phase<pg8::EpiConv, pg8::StaticOrder, true, true, true>(ldsl, g, S, E);
    }
    GRID_BAR();
    PH(6) { PHASE_LOCALS
        const float* cw = args.in[14]; const float* cb = args.in[15];
        for (int it = bx * 512 + tid; it < 256 * 1024; it += G * 512) {
            const int span = it >> 10, f = (it & 1023) * 4;
            if ((span & 63) == 0) continue;
            const float* us = UB + (size_t)(span * 4) * 8192 + f; const float* up = UB + (size_t)((span - 1) * 4) * 8192 + f;
            float a0[4], a1[4];
            f32x4 cg0, cg1, cv0, cv1;
            { const f32x4 w0 = *(const f32x4*)(cw + f), w1 = *(const f32x4*)(cw + 8192 + f), w2 = *(const f32x4*)(cw + 16384 + f), bb = *(const f32x4*)(cb + f);
              const f32x4 u0 = *(const f32x4*)us, u1 = *(const f32x4*)(us + 8192), um2 = *(const f32x4*)(up + 2 * 8192), um1 = *(const f32x4*)(up + 3 * 8192);
              cg0 = bb + w2 * u0 + w1 * um1 + w0 * um2; cg1 = bb + w2 * u1 + w1 * u0 + w0 * um1; }
            { const f32x4 w0 = *(const f32x4*)(cw + 4096 + f), w1 = *(const f32x4*)(cw + 8192 + 4096 + f), w2 = *(const f32x4*)(cw + 16384 + 4096 + f), bb = *(const f32x4*)(cb + 4096 + f);
              const f32x4 u0 = *(const f32x4*)(us + 4096), u1 = *(const f32x4*)(us + 8192 + 4096), um2 = *(const f32x4*)(up + 2 * 8192 + 4096), um1 = *(const f32x4*)(up + 3 * 8192 + 4096);
              cv0 = bb + w2 * u0 + w1 * um1 + w0 * um2; cv1 = bb + w2 * u1 + w1 * u0 + w0 * um1; }
#pragma unroll
            for (int e = 0; e < 4; ++e) { a0[e] = pg8::gelu_tanh_gate(cg0[e]) * cv0[e]; a1[e] = pg8::gelu_tanh_gate(cg1[e]) * cv1[e]; }
            v2u w0; w0.x = pk2(a0[0], a0[1]); w0.y = pk2(a0[2], a0[3]); v2u w1; w1.x = pk2(a1[0], a1[1]); w1.y = pk2(a1[2], a1[3]);
            *(v2u*)(ACT + (size_t)(span * 128) * DFF + f) = w0; *(v2u*)(ACT + (size_t)(span * 128 + 1) * DFF + f) = w1;
        }
    }
    GRID_BAR();

    PH(7) { PHASE_LOCALS
        pg8::Gemm g{ACT, Wt_dn, MTOK, DM, DFF}; pg8::StaticOrder S; S.init(MTOK, DM, G, bx);
        pg8::EpiBf16<0> E{FRAW, DM, nullptr, 0, 0, 1.f};
        pg8::gemm_phase<pg8::EpiBf16<0>, pg8::StaticOrder, true, true>(ldsl, g, S, E);
    }
    GRID_BAR();
    PH(8) { PHASE_LOCALS
        for (int m = gw; m < MTOK; m += NGW) post_row<false>(FRAW + (size_t)m * DM, args.out + (size_t)m * DM, args.in[17], args.out + (size_t)m * DM, nullptr, lane); }
}

extern "C" void kernel_launch(void* const* d_in, const int* in_sizes, int n_in, void* d_out, int out_size, void* d_ws, size_t ws_size, hipStream_t stream) {
    static int grid = 0;
    if (grid == 0) {
        if (n_in != 18 || in_sizes[0] != MTOK * DM || out_size != MTOK * DM || ws_size < WS_END) {
            fprintf(stderr, "kernel_launch: unexpected problem shape (n_in %d, in0 %d, out %d, ws %zu); nothing launched\n", n_in, n_in > 0 ? in_sizes[0] : -1, out_size, ws_size); grid = -1; return; }
        int dev = 0, cus = 0, per_cu = 0;
        if (hipGetDevice(&dev) != hipSuccess || hipDeviceGetAttribute(&cus, hipDeviceAttributeMultiprocessorCount, dev) != hipSuccess) { grid = -1; return; }
        if (hipFuncSetAttribute((const void*)hymba_fwd, hipFuncAttributeMaxDynamicSharedMemorySize, LDS_BYTES) != hipSuccess) { fprintf(stderr, "kernel_launch: hipFuncSetAttribute failed\n"); grid = -1; return; }
        if (hipOccupancyMaxActiveBlocksPerMultiprocessor(&per_cu, (const void*)hymba_fwd, NWAVES * 64, LDS_BYTES) != hipSuccess || per_cu < 1) { fprintf(stderr, "kernel_launch: occupancy query says %d blocks per CU\n", per_cu); per_cu = 1; }
        (void)hipGetLastError();
        grid = cus;
    }
    if (grid < 0) return;
    if (hipMemsetAsync((char*)d_ws + WS_CTL, 0, 65536, stream) != hipSuccess) { fprintf(stderr, "kernel_launch: hipMemsetAsync failed\n"); return; }
    Args a{};
    for (int i = 0; i < 18; ++i) a.in[i] = (const float*)d_in[i];
    a.out = (float*)d_out; a.ws = (unsigned char*)d_ws;
    void* kargs[] = {&a};
    hipError_t e = hipLaunchCooperativeKernel((const void*)hymba_fwd, dim3(grid), dim3(NWAVES * 64), kargs, LDS_BYTES, stream);
    if (e != hipSuccess) fprintf(stderr, "kernel_launch: cooperative launch failed: %s (grid %d)\n", hipGetErrorString(e), grid);
}
```

```cpp
#include <hip/hip_runtime.h>
#include <hip/hip_cooperative_groups.h>
#include <hip/hip_bf16.h>
#include <cstdio>
#include <cstdint>
namespace cg = cooperative_groups;

namespace pg8 {
#define PG8_LAS __attribute__((address_space(3)))
typedef unsigned short bf16_t;
typedef short bf16x8 __attribute__((ext_vector_type(8)));
typedef float f32x4 __attribute__((ext_vector_type(4)));
typedef unsigned u32x4 __attribute__((ext_vector_type(4)));
constexpr int BM = 256, BK = 64, HALF = 128, HTB = HALF * BK * 2  , STAGE_BYTES = 8 * HTB, NXCD = 8, WGM = 8;

__host__ __device__ __forceinline__ int lds_byte(int r, int c) { const int st = (r >> 4) * 2 + (c >> 5), rr = r & 15, cc = c & 31, ob = rr * 64 + cc * 2; return st * 1024 + (ob ^ (((ob >> 9) & 1) << 5)); }
__host__ __device__ __forceinline__ void stage_rc(int b, int& R, int& C) { const int st = b / 1024, sb = b % 1024, swz = sb ^ (((sb >> 9) & 1) << 5); R = (st >> 1) * 16 + swz / 64; C = (st & 1) * 32 + (swz % 64) / 2; }
__host__ __device__ __forceinline__ int perm32(int rho) { const int n = rho >> 4, i = rho & 15; return 8 * (i >> 2) + 4 * n + (i & 3); }

struct Unit { int pm, pn; };
struct Gemm { const bf16_t* A; const bf16_t* Bt; int M, N, K; };

struct StaticOrder {
    int nM, nN, nwg, G, c;
    __host__ __device__ void init(int M, int N, int G_, int c_) { nM = M / BM; nN = N / BM; nwg = nM * nN; G = G_; c = c_; }
    __host__ __device__ bool next(int i, Unit& u) const {
        const long L = (long)i * G + c; if (L >= nwg) return false;
        int wgid = (int)L; { const int q = nwg / NXCD, r = nwg % NXCD, xcd = wgid % NXCD, off = wgid / NXCD; wgid = (xcd < r ? xcd * (q + 1) : r * (q + 1) + (xcd - r) * q) + off; }
        const int nig = WGM * nN, gid = wgid / nig, fm = gid * WGM, gsz = (nM - fm) < WGM ? (nM - fm) : WGM;
        u.pm = fm + ((wgid % nig) % gsz); u.pn = (wgid % nig) / gsz; return true;
    }
    __device__ __forceinline__ void a_ready(const Unit&) const {}
    __device__ __forceinline__ void done(const Unit&) const {}
};
__device__ __forceinline__ unsigned cvt_pk_bf16(float lo, float hi) { unsigned r; asm volatile("v_cvt_pk_bf16_f32 %0, %1, %2" : "=v"(r) : "v"(lo), "v"(hi)); return r; }
typedef float f32x2 __attribute__((ext_vector_type(2)));
__device__ __forceinline__ f32x2 gelu_pk(f32x2 v) {
    const f32x2 av = __builtin_elementwise_abs(v), d = av * 0.2316418882f + 1.0f;
    f32x2 t; t.x = __builtin_amdgcn_rcpf(d.x); t.y = __builtin_amdgcn_rcpf(d.y);
    f32x2 q = t * 0.5307027145f + (-0.7265760135f); q = q * t + 0.7107068705f; q = q * t + (-0.142248368f); q = q * t + 0.127414796f; q = q * t;
    const f32x2 s = (v * v) * (-0.72134752044f);
    f32x2 e; e.x = __builtin_amdgcn_exp2f(s.x); e.y = __builtin_amdgcn_exp2f(s.y);
    const f32x2 m = v * (q * e), r = v - m;
    f32x2 o; o.x = v.x < 0.f ? m.x : r.x; o.y = v.y < 0.f ? m.y : r.y; return o;
}

template <int ACT  > struct EpiBf16 {
    static constexpr bool PERM = true, AFTER_DRAIN = false; static_assert(ACT == 0 || ACT == 1, "EpiBf16: ACT is 0 (none) or 1 (gelu_pk)");
    bf16_t* O; int ldc; const float* bias; int split_cols; size_t split_stride; float scale0;
    __device__ __forceinline__ void operator()(const f32x4 (&acc)[2][2][4][2], const Unit& u, int wr, int wc, int fr, int fq) const {
        const int row0 = u.pm * BM + wr * 64 + fr; int colt = u.pn * BM; bf16_t* base = O;
        float sc = 1.f; if (split_cols) { const int t = colt / split_cols; base += (size_t)t * split_stride; colt -= t * split_cols; if (t == 0) sc = scale0; }
        const int col0 = colt + wc * 32 + 8 * fq, bcol0 = u.pn * BM + wc * 32 + 8 * fq;
        f32x4 bv[2][2];
#pragma unroll
        for (int bj = 0; bj < 2; ++bj)
#pragma unroll
            for (int n = 0; n < 2; ++n) bv[bj][n] = bias ? *(const f32x4*)(bias + bcol0 + bj * HALF + 4 * n) : (f32x4){0.f, 0.f, 0.f, 0.f};
#pragma unroll
        for (int ai = 0; ai < 2; ++ai)
#pragma unroll
            for (int m = 0; m < 4; ++m) { bf16_t* rowp = base + (size_t)(row0 + ai * HALF + m * 16) * ldc + col0;
#pragma unroll
                for (int bj = 0; bj < 2; ++bj) { f32x4 v0 = acc[ai][bj][m][0] + bv[bj][0], v1 = acc[ai][bj][m][1] + bv[bj][1];
                    if (ACT == 1) { f32x2 a = gelu_pk((f32x2){v0[0], v0[1]}), b = gelu_pk((f32x2){v0[2], v0[3]}), c = gelu_pk((f32x2){v1[0], v1[1]}), d = gelu_pk((f32x2){v1[2], v1[3]});
                        v0 = (f32x4){a.x, a.y, b.x, b.y}; v1 = (f32x4){c.x, c.y, d.x, d.y}; }
                    v0 = v0 * sc; v1 = v1 * sc; u32x4 w; w.x = cvt_pk_bf16(v0[0], v0[1]); w.y = cvt_pk_bf16(v0[2], v0[3]); w.z = cvt_pk_bf16(v1[0], v1[1]); w.w = cvt_pk_bf16(v1[2], v1[3]);
                    *(u32x4*)(rowp + bj * HALF) = w; } }
    }
};

struct EpiProj {
    static constexpr bool PERM = true, AFTER_DRAIN = false;
    bf16_t *QA, *KA, *VA, *QB, *KB, *VB;
    __device__ __forceinline__ void operator()(const f32x4 (&acc)[2][2][4][2], const Unit& u, int wr, int wc, int fr, int fq) const {
        const int pn = u.pn;
        const int b = u.pm >> 5;
#pragma unroll
        for (int bj = 0; bj < 2; ++bj) {
            bf16_t* base; int rstride; float beta = 0.f; int mode = 0;
            if (pn < 2)       { base = QA + pn * 256 + bj * 128 + wc * 32 + fq * 8; rstride = 512; }
            else if (pn == 2) { base = (bj == 0 ? KA : VA) + wc * 32 + fq * 8; rstride = 128; }
            else if (pn < 5)  { base = QB + (pn - 3) * 256 + bj * 128 + wc * 32 + fq * 8; rstride = 512; }
            else if (pn < 7)  { const int h = 2 * (pn - 5) + bj, mm = wc >> 1, c = 4 * (wc & 1) + fq; mode = 1; rstride = 0;
                                base = KB + ((size_t)((b * 4 + h) * 2 + mm) * 128) * 4096 + c * 512; }
            else              { const int h = 2 * (pn - 7) + bj; mode = 2; rstride = 0; beta = 1.4426950408889634f * __builtin_amdgcn_exp2f(-(float)(5 + h));
                                base = VB + ((size_t)(b * 4 + h) * 128) * 8192 + wc * 2048 + fq * 8; }
#pragma unroll
            for (int ai = 0; ai < 2; ++ai)
#pragma unroll
                for (int m = 0; m < 4; ++m) {
                    const int rl = ai * 128 + wr * 64 + m * 16 + fr;
                    const int row = u.pm * 256 + rl;
                    const int s = row & 8191, tile = s >> 6, key = s & 63;
                    f32x4 v0 = acc[ai][bj][m][0], v1 = acc[ai][bj][m][1];
                    bf16_t* p;
                    if (mode == 0) p = base + (size_t)row * rstride;
                    else if (mode == 1) p = base + (size_t)tile * 4096 + key * 8;
                    else { p = base + (size_t)tile * 8192 + (key >> 4) * 512 + (key & 15) * 32; const float w = __builtin_amdgcn_exp2f(beta * (float)key); v0 = v0 * w; v1 = v1 * w; }
                    u32x4 o; o.x = cvt_pk_bf16(v0[0], v0[1]); o.y = cvt_pk_bf16(v0[2], v0[3]); o.z = cvt_pk_bf16(v1[0], v1[1]); o.w = cvt_pk_bf16(v1[2], v1[3]);
                    *(u32x4*)p = o;
                }
        }
    }
};

__device__ __forceinline__ float dpp_shr1(float v) { return __int_as_float(__builtin_amdgcn_update_dpp(0, __float_as_int(v), 0x111, 0xf, 0xf, true)); }
__device__ __forceinline__ f32x4 dpp_shr1x4(f32x4 v) { return (f32x4){dpp_shr1(v[0]), dpp_shr1(v[1]), dpp_shr1(v[2]), dpp_shr1(v[3])}; }
__device__ __forceinline__ float gelu_tanh_gate(float x) {
    const float t = x * x, z = x * (2.3022081985f + 0.1029432397f * t);
    return x * __builtin_amdgcn_rcpf(1.0f + __builtin_amdgcn_exp2f(-z));
}
struct EpiConv {
    static constexpr bool PERM = true, AFTER_DRAIN = false;
    bf16_t* ACT; float* UB; const float* cw; const float* cb;
    __device__ __forceinline__ void operator()(const f32x4 (&acc)[2][2][4][2], const Unit& u, int wr, int wc, int fr, int fq) const {
        const int tok0 = u.pm * 256 + wr * 128 + fr * 8, span = u.pm * 2 + wr;
        unsigned keep[8][2];
#pragma unroll
        for (int n = 0; n < 2; ++n) {
            const int f = u.pn * 128 + wc * 32 + fq * 8 + n * 4;
            const f32x4 wg0 = *(const f32x4*)(cw + f), wg1 = *(const f32x4*)(cw + 8192 + f), wg2 = *(const f32x4*)(cw + 16384 + f), bg = *(const f32x4*)(cb + f);
            const f32x4 wv0 = *(const f32x4*)(cw + 4096 + f), wv1 = *(const f32x4*)(cw + 8192 + 4096 + f), wv2 = *(const f32x4*)(cw + 16384 + 4096 + f), bv = *(const f32x4*)(cb + 4096 + f);
#define UG(j) acc[(j) >> 2][0][(j) & 3][n]
#define UV(j) acc[(j) >> 2][1][(j) & 3][n]
            const f32x4 pg1 = dpp_shr1x4(UG(7)), pg2 = dpp_shr1x4(UG(6)), pv1 = dpp_shr1x4(UV(7)), pv2 = dpp_shr1x4(UV(6));
            if (fr == 0) { float* q = UB + (size_t)(span * 4) * 8192 + f; *(f32x4*)q = UG(0); *(f32x4*)(q + 8192) = UG(1); *(f32x4*)(q + 4096) = UV(0); *(f32x4*)(q + 8192 + 4096) = UV(1); }
            if (fr == 15) { float* q = UB + (size_t)(span * 4 + 2) * 8192 + f; *(f32x4*)q = UG(6); *(f32x4*)(q + 8192) = UG(7); *(f32x4*)(q + 4096) = UV(6); *(f32x4*)(q + 8192 + 4096) = UV(7); }
#pragma unroll
            for (int j = 0; j < 8; ++j) {
                const f32x4 g1 = j >= 1 ? UG(j >= 1 ? j - 1 : 0) : pg1, g2 = j >= 2 ? UG(j >= 2 ? j - 2 : 0) : (j == 1 ? pg1 : pg2);
                const f32x4 v1 = j >= 1 ? UV(j >= 1 ? j - 1 : 0) : pv1, v2 = j >= 2 ? UV(j >= 2 ? j - 2 : 0) : (j == 1 ? pv1 : pv2);
                const f32x4 cgv = bg + wg2 * UG(j) + wg1 * g1 + wg0 * g2;
                const f32x4 cvv = bv + wv2 * UV(j) + wv1 * v1 + wv0 * v2;
                const float a0 = gelu_tanh_gate(cgv[0]) * cvv[0], a1 = gelu_tanh_gate(cgv[1]) * cvv[1], a2 = gelu_tanh_gate(cgv[2]) * cvv[2], a3 = gelu_tanh_gate(cgv[3]) * cvv[3];
                const unsigned lo = cvt_pk_bf16(a0, a1), hi = cvt_pk_bf16(a2, a3);
                if (n == 0) { keep[j][0] = lo; keep[j][1] = hi; }
                else { u32x4 o; o.x = keep[j][0]; o.y = keep[j][1]; o.z = lo; o.w = hi; *(u32x4*)(ACT + (size_t)(tok0 + j) * 4096 + u.pn * 128 + wc * 32 + fq * 8) = o; }
            }
#undef UG
#undef UV
        }
    }
};
template <class Epi, class Sched, bool ALIGN_EPI = false, bool SP2 = false, bool ROWPERM = false>
__device__ __forceinline__ void gemm_phase(PG8_LAS unsigned char* lds, const Gemm g, const Sched& S, const Epi& E) {
    int tid_ = threadIdx.x; asm volatile("" : "+v"(tid_));
    const int tid = tid_, wid = __builtin_amdgcn_readfirstlane(tid >> 6), lane = tid & 63, wr = wid >> 2, wc = wid & 3, fr = lane & 15, fq = lane >> 4;
    const int K = g.K, nt = K / BK;
    unsigned voffA[2], voffB[2];
#pragma unroll
    for (int i = 0; i < 2; ++i) { int R, C; stage_rc(tid * 16 + i * 8192, R, C); const int Rb = Epi::PERM ? ((R & ~31) + perm32(R & 31)) : R;
        const int Ra = ROWPERM ? ((R >> 6) * 128 + (R & 15) * 8 + ((R >> 4) & 3)) : R;
        voffA[i] = (unsigned)(Ra * K + C) * 2u; voffB[i] = (unsigned)(Rb * K + C) * 2u; }
    const size_t kstep = (size_t)(BK * 2);
    const size_t hstepB = (size_t)HALF * K * 2;
    const size_t hstepA = ROWPERM ? (size_t)4 * K * 2 : hstepB;
    const size_t tstep = 2 * hstepB;
    const unsigned ldsw = (unsigned)wid * 1024u;
    const int aoff = lds_byte(wr * 64 + fr, fq * 8), boff = lds_byte(wc * 32 + fr, fq * 8);
#define PG8_SA(b, h) (((b) * 2 + (h)) * HTB)
#define PG8_SB(b, h) ((4 + (b) * 2 + (h)) * HTB)
#define PG8_STAGE(bufoff, gbase, voff) do { _Pragma("unroll") for (int _i = 0; _i < 2; ++_i) \
        __builtin_amdgcn_global_load_lds((const unsigned*)((const char*)(gbase) + (voff)[_i]), (PG8_LAS unsigned*)(lds + (bufoff) + ldsw + _i * 8192), 16, 0, 0); } while (0)
#define PG8_LDA(dst, b, h) do { _Pragma("unroll") for (int m = 0; m < 4; ++m) _Pragma("unroll") for (int k = 0; k < 2; ++k) dst[m][k] = *(const PG8_LAS bf16x8*)(lds + PG8_SA(b, h) + aoff + m * 2048 + k * 1024); } while (0)
#define PG8_LDB(dst, b, h) do { _Pragma("unroll") for (int n = 0; n < 2; ++n) _Pragma("unroll") for (int k = 0; k < 2; ++k) dst[n][k] = *(const PG8_LAS bf16x8*)(lds + PG8_SB(b, h) + boff + n * 2048 + k * 1024); } while (0)
#define PG8_MMA(ai, bj, At, Bt) do { __builtin_amdgcn_s_setprio(1); _Pragma("unroll") for (int m = 0; m < 4; ++m) _Pragma("unroll") for (int n = 0; n < 2; ++n) _Pragma("unroll") for (int k = 0; k < 2; ++k) \
        acc[ai][bj][m][n] = __builtin_amdgcn_mfma_f32_16x16x32_bf16(Bt[n][k], At[m][k], acc[ai][bj][m][n], 0, 0, 0); __builtin_amdgcn_s_setprio(0); } while (0)
#define PG8_WAIT_V(n) asm volatile("s_waitcnt vmcnt(" #n ")" ::: "memory")
#define PG8_WAIT_L(n) asm volatile("s_waitcnt lgkmcnt(" #n ")" ::: "memory")
#define PG8_BAR __builtin_amdgcn_s_barrier()
#define PG8_SCHED __builtin_amdgcn_sched_barrier(0)
    Unit cur, nxt; int ui = 0;
    if (!S.next(0, cur)) return;
    f32x4 acc[2][2][4][2];
#pragma unroll
    for (int a = 0; a < 2; ++a)
#pragma unroll
        for (int b = 0; b < 2; ++b)
#pragma unroll
            for (int m = 0; m < 4; ++m)
#pragma unroll
                for (int n = 0; n < 2; ++n) acc[a][b][m][n] = (f32x4){0.f, 0.f, 0.f, 0.f};
    bf16x8 At[4][2], B0[2][2], B1[2][2];
    const char* cA = (const char*)g.A + (size_t)cur.pm * tstep; const char* cB = (const char*)g.Bt + (size_t)cur.pn * tstep;
    S.a_ready(cur);
    if constexpr (SP2) {
        PG8_STAGE(PG8_SB(0, 0), cB, voffB); PG8_STAGE(PG8_SB(0, 1), cB + hstepB, voffB); PG8_STAGE(PG8_SA(0, 0), cA, voffA); PG8_STAGE(PG8_SA(0, 1), cA + hstepA, voffA);
        if (wr == 1) PG8_BAR;
        PG8_WAIT_V(2); PG8_BAR;
        PG8_STAGE(PG8_SB(1, 0), cB + kstep, voffB); PG8_STAGE(PG8_SA(1, 0), cA + kstep, voffA); PG8_STAGE(PG8_SB(1, 1), cB + hstepB + kstep, voffB);
        PG8_WAIT_V(6); PG8_BAR;
    } else {
        PG8_STAGE(PG8_SB(0, 0), cB, voffB); PG8_STAGE(PG8_SA(0, 0), cA, voffA); PG8_STAGE(PG8_SB(0, 1), cB + hstepB, voffB); PG8_STAGE(PG8_SA(0, 1), cA + hstepA, voffA);
        if (wr == 1) PG8_BAR;
        PG8_WAIT_V(4); PG8_BAR;
        PG8_STAGE(PG8_SB(1, 0), cB + kstep, voffB); PG8_STAGE(PG8_SA(1, 0), cA + kstep, voffA); PG8_STAGE(PG8_SB(1, 1), cB + hstepB + kstep, voffB);
        PG8_WAIT_V(6); PG8_BAR;
    }
    for (;;) {
        const bool has_next = S.next(ui + 1, nxt);
        const char* nA = has_next ? (const char*)g.A + (size_t)nxt.pm * tstep : cA; const char* nB = has_next ? (const char*)g.Bt + (size_t)nxt.pn * tstep : cB;
        for (int t = 0; t < nt; t += 2) {
            const bool last = (t == nt - 2);
            const char* a1 = cA + (size_t)(t + 1) * kstep;
            const char* a2 = last ? nA : cA + (size_t)(t + 2) * kstep; const char* b2 = last ? nB : cB + (size_t)(t + 2) * kstep;
            const char* a3 = a2 + kstep; const char* b3 = b2 + kstep;
            if (last && has_next) S.a_ready(nxt);
            if constexpr (SP2) {
            PG8_LDB(B0, 0, 0); PG8_LDB(B1, 0, 1); PG8_SCHED; PG8_LDA(At, 0, 0); PG8_STAGE(PG8_SA(1, 1), a1 + hstepA, voffA);
            PG8_WAIT_V(8); PG8_WAIT_L(0); PG8_BAR; PG8_MMA(0, 0, At, B0); PG8_MMA(0, 1, At, B1); PG8_BAR; PG8_SCHED;
            PG8_LDA(At, 0, 1); PG8_STAGE(PG8_SB(0, 0), b2, voffB); PG8_STAGE(PG8_SB(0, 1), b2 + hstepB, voffB); PG8_STAGE(PG8_SA(0, 0), a2, voffA);
            PG8_WAIT_V(8); PG8_WAIT_L(0); PG8_BAR; PG8_MMA(1, 0, At, B0); PG8_MMA(1, 1, At, B1); PG8_BAR; PG8_SCHED;
            PG8_LDB(B0, 1, 0); PG8_LDB(B1, 1, 1); PG8_SCHED; PG8_LDA(At, 1, 0); PG8_STAGE(PG8_SA(0, 1), a2 + hstepA, voffA);
            PG8_WAIT_V(8); PG8_WAIT_L(0); PG8_BAR; PG8_MMA(0, 0, At, B0); PG8_MMA(0, 1, At, B1); PG8_BAR; PG8_SCHED;
            PG8_LDA(At, 1, 1); PG8_STAGE(PG8_SB(1, 0), b3, voffB); PG8_STAGE(PG8_SB(1, 1), b3 + hstepB, voffB); PG8_STAGE(PG8_SA(1, 0), a3, voffA);
            PG8_WAIT_V(8); PG8_WAIT_L(0); PG8_BAR; PG8_MMA(1, 0, At, B0); PG8_MMA(1, 1, At, B1); PG8_BAR; PG8_SCHED;
            } else {
            PG8_LDB(B0, 0, 0); PG8_SCHED; PG8_LDA(At, 0, 0); PG8_STAGE(PG8_SA(1, 1), a1 + hstepA, voffA);
            PG8_WAIT_L(8); PG8_BAR; PG8_WAIT_L(0); PG8_MMA(0, 0, At, B0); PG8_BAR; PG8_SCHED;
            PG8_LDB(B1, 0, 1); PG8_STAGE(PG8_SB(0, 0), b2, voffB);
            PG8_BAR; PG8_WAIT_L(0); PG8_MMA(0, 1, At, B1); PG8_BAR;
            PG8_LDA(At, 0, 1); PG8_STAGE(PG8_SA(0, 0), a2, voffA);
            PG8_BAR; PG8_WAIT_L(0); PG8_MMA(1, 0, At, B0); PG8_BAR; PG8_SCHED;
            PG8_STAGE(PG8_SB(0, 1), b2 + hstepB, voffB);
            PG8_WAIT_V(6); PG8_BAR; PG8_MMA(1, 1, At, B1); PG8_BAR;
            PG8_LDB(B0, 1, 0); PG8_SCHED; PG8_LDA(At, 1, 0); PG8_STAGE(PG8_SA(0, 1), a2 + hstepA, voffA);
            PG8_WAIT_L(8); PG8_BAR; PG8_WAIT_L(0); PG8_MMA(0, 0, At, B0); PG8_BAR; PG8_SCHED;
            PG8_LDB(B1, 1, 1); PG8_STAGE(PG8_SB(1, 0), b3, voffB);
            PG8_BAR; PG8_WAIT_L(0); PG8_MMA(0, 1, At, B1); PG8_BAR;
            PG8_LDA(At, 1, 1); PG8_STAGE(PG8_SA(1, 0), a3, voffA);
            PG8_BAR; PG8_WAIT_L(0); PG8_MMA(1, 0, At, B0); PG8_BAR; PG8_SCHED;
            PG8_STAGE(PG8_SB(1, 1), b3 + hstepB, voffB);
            PG8_WAIT_V(6); PG8_BAR; PG8_MMA(1, 1, At, B1); PG8_BAR;
            }
        }
        if constexpr (ALIGN_EPI) { if (wr == 0) PG8_BAR; }
        if constexpr (!Epi::AFTER_DRAIN) { E(acc, cur, wr, wc, fr, fq); S.done(cur); }
        if (!has_next) break;
#pragma unroll
        for (int a = 0; a < 2; ++a)
#pragma unroll
            for (int b = 0; b < 2; ++b)
#pragma unroll
                for (int m = 0; m < 4; ++m)
#pragma unroll
                    for (int n = 0; n < 2; ++n) acc[a][b][m][n] = (f32x4){0.f, 0.f, 0.f, 0.f};
        cur = nxt; cA = nA; cB = nB; ++ui;
        if constexpr (ALIGN_EPI) { if (wr == 1) PG8_BAR; }
    }
    PG8_WAIT_V(0);
    if constexpr (!ALIGN_EPI) { if (wr == 0) PG8_BAR; }
    PG8_BAR;
    if constexpr (Epi::AFTER_DRAIN) { E.fused(acc, cur, wr, wc, fr, fq, lds, wid, lane); S.done(cur); }
#undef PG8_SA
#undef PG8_SB
#undef PG8_STAGE
#undef PG8_LDA
#undef PG8_LDB
#undef PG8_MMA
#undef PG8_WAIT_V
#undef PG8_WAIT_L
#undef PG8_BAR
#undef PG8_SCHED
}
}

namespace att {
#define LAS __attribute__((address_space(3)))
typedef unsigned short bf16;
typedef short bf16x8 __attribute__((ext_vector_type(8)));
typedef short s16x4 __attribute__((ext_vector_type(4)));
typedef float f32x16 __attribute__((ext_vector_type(16)));
typedef float f32x4 __attribute__((ext_vector_type(4)));
typedef unsigned u32x4 __attribute__((ext_vector_type(4)));
typedef unsigned u32x2 __attribute__((ext_vector_type(2)));
typedef float f32x2_t __attribute__((ext_vector_type(2)));
typedef __bf16 bf16x2_t __attribute__((ext_vector_type(2)));
typedef short v4i16_t __attribute__((ext_vector_type(4)));
typedef LAS const char* lds_cptr;
constexpr int SEQ = 8192;
constexpr float LOG2E = 1.4426950408889634f;
#define MFMA32(a, b, c) __builtin_amdgcn_mfma_f32_32x32x16_bf16(a, b, c, 0, 0, 0)
__device__ __forceinline__ int crow(int r, int hi) { return (r & 3) + 8 * (r >> 2) + 4 * hi; }
__device__ __forceinline__ unsigned cvtpk(float lo, float hi) { f32x2_t v = {lo, hi}; bf16x2_t b = __builtin_convertvector(v, bf16x2_t); return __builtin_bit_cast(unsigned, b); }
__device__ __forceinline__ void glds16(const void* gsrc, unsigned lds_dst) { unsigned keep;
    asm volatile("s_mov_b32 %0, m0\n\ts_mov_b32 m0, %2\n\ts_nop 0\n\tglobal_load_lds_dwordx4 %1, off\n\ts_mov_b32 m0, %0" : "=&s"(keep) : "v"(gsrc), "s"(lds_dst) : "memory"); }
__device__ __forceinline__ s16x4 vtr(lds_cptr p) { return __builtin_bit_cast(s16x4, __builtin_amdgcn_ds_read_tr16_b64_v4i16((LAS v4i16_t*)p)); }
__device__ __forceinline__ bf16x8 kfrag(lds_cptr p) { return *(const LAS bf16x8*)p; }
#define MX3(a, b, c) __builtin_fmaxf(__builtin_fmaxf((a), (b)), (c))
__device__ __forceinline__ float half_swap_max(float m) { auto rr = __builtin_amdgcn_permlane32_swap(__float_as_uint(m), __float_as_uint(m), false, false); return __builtin_fmaxf(__uint_as_float(rr[0]), __uint_as_float(rr[1])); }
__device__ __forceinline__ float half_swap_sum(float m) { auto rr = __builtin_amdgcn_permlane32_swap(__float_as_uint(m), __float_as_uint(m), false, false); return __uint_as_float(rr[0]) + __uint_as_float(rr[1]); }
__device__ __forceinline__ float rowmax2(const f32x16& p0, const f32x16& p1) {
    float a = MX3(p0[0], p0[1], p1[0]), b = MX3(p0[2], p0[3], p1[1]); a = MX3(a, p1[2], p1[3]);
#pragma unroll
    for (int r = 4; r < 16; r += 4) { a = MX3(a, p0[r], p0[r + 1]); b = MX3(b, p0[r + 2], p0[r + 3]); a = MX3(a, p1[r], p1[r + 1]); b = MX3(b, p1[r + 2], p1[r + 3]); }
    return half_swap_max(__builtin_fmaxf(a, b)); }
#define WAIT_BAR(N) asm volatile("s_waitcnt vmcnt(" #N ") lgkmcnt(0)\n\ts_barrier" ::: "memory")
#define PKF(P, i) cvtpk(P[i], P[i + 1])

constexpr int DK_SLOT = 8192, DV_SLOT = 16384, D_NSLOT = 4, D_LDS_K = 0, D_LDS_V = D_NSLOT * DK_SLOT;
template <int THRL>
__device__ __forceinline__ void diff_pass(int b, int h, int m, int qb, const bf16* QB, const bf16* KB, const bf16* VB, char* shm, f32x16 (&o)[4], float& l_out) {
    int tid_ = threadIdx.x; asm volatile("" : "+v"(tid_));
    const int tid = tid_, lane = tid & 63, r32 = lane & 31, hi = lane >> 5; const int wid = __builtin_amdgcn_readfirstlane(tid >> 6);
    const bool late = wid >= 4;
    const long rowbase = (long)b * SEQ; const int q0 = qb * 256;
    const bf16* Qw = QB + (rowbase + q0 + wid * 32) * 512 + h * 128 + m * 64;
    const char* Kt = (const char*)KB + ((size_t)((b * 4 + h) * 2 + m) * 128) * 8192 + wid * 1024 + lane * 16;
    const char* Vt = (const char*)VB + ((size_t)(b * 4 + h) * 128) * 16384 + wid * 1024 + lane * 16;
    const unsigned lds0 = (unsigned)(uintptr_t)shm;
    const unsigned kdst = lds0 + D_LDS_K + wid * 1024, vdst = lds0 + D_LDS_V + wid * 1024;
#define DMA_T(t, s) do { glds16(Kt + (size_t)(t) * 8192, (unsigned)__builtin_amdgcn_readfirstlane(kdst + (s) * DK_SLOT)); \
        glds16(Vt + (size_t)(t) * 16384, (unsigned)__builtin_amdgcn_readfirstlane(vdst + (s) * DV_SLOT)); \
        glds16(Vt + (size_t)(t) * 16384 + 8192, (unsigned)__builtin_amdgcn_readfirstlane(vdst + (s) * DV_SLOT + 8192)); } while (0)
    const lds_cptr shm3 = (lds_cptr)shm;
    const lds_cptr kp0 = shm3 + D_LDS_K + hi * 1024 + r32 * 16;
    const lds_cptr vp0 = shm3 + D_LDS_V + ((lane >> 4) & 1) * 32 + (lane & 3) * 8 + (4 * hi + ((lane & 15) >> 2)) * 64;
    const int NT = 4 * (qb + 1);
    DMA_T(0, 0); DMA_T(1, 1);
    bf16x8 qr[4];
#pragma unroll
    for (int d0 = 0; d0 < 4; ++d0) qr[d0] = *reinterpret_cast<const bf16x8*>(&Qw[(long)r32 * 512 + d0 * 16 + hi * 8]);
    const float beta = LOG2E * __builtin_amdgcn_exp2f(-(float)(5 + h));
    const float B64 = 64.f * beta, W32 = __builtin_amdgcn_exp2f(32.f * beta), Whi = hi ? __builtin_amdgcn_exp2f(4.f * beta) : 1.f;
    float Wr[16];
#pragma unroll
    for (int r = 0; r < 16; ++r) Wr[r] = __uint_as_float(__builtin_amdgcn_readfirstlane(__float_as_uint(__builtin_amdgcn_exp2f(beta * (float)((r & 3) + 8 * (r >> 2))))));
#pragma unroll
    for (int d = 0; d < 4; ++d) o[d] = f32x16{};
    float mref = 0.f, l_reg = 0.f;
    const int qrel = wid * 32 + r32;
    asm volatile("" :: "v"(qr[0]), "v"(qr[1]), "v"(qr[2]), "v"(qr[3]));
    u32x4 pw[4];
#pragma unroll
    for (int k = 0; k < 4; ++k) pw[k] = (u32x4){0u, 0u, 0u, 0u};
#define VLOAD(dst, d0) do { _Pragma("unroll") for (int ks = 0; ks < 4; ++ks) { dst[2 * ks] = vtr(vp + (d0) * 4096 + ks * 1024); dst[2 * ks + 1] = vtr(vp + (d0) * 4096 + ks * 1024 + 512); } } while (0)
#define VMMA(src, d0) do { _Pragma("unroll") for (int ks = 0; ks < 4; ++ks) { const bf16x8 vf = (bf16x8){src[2 * ks][0], src[2 * ks][1], src[2 * ks][2], src[2 * ks][3], src[2 * ks + 1][0], src[2 * ks + 1][1], src[2 * ks + 1][2], src[2 * ks + 1][3]}; \
            o[d0] = MFMA32(vf, __builtin_bit_cast(bf16x8, pw[ks]), o[d0]); } } while (0)
#define PV_STEP(s) do { const lds_cptr vp = vp0 + (s) * DV_SLOT; s16x4 va[8], vb[8]; \
        VLOAD(va, 0); __builtin_amdgcn_sched_barrier(0); \
        VLOAD(vb, 1); __builtin_amdgcn_sched_barrier(0); VMMA(va, 0); __builtin_amdgcn_sched_barrier(0); \
        VLOAD(va, 2); __builtin_amdgcn_sched_barrier(0); VMMA(vb, 1); __builtin_amdgcn_sched_barrier(0); \
        VLOAD(vb, 3); __builtin_amdgcn_sched_barrier(0); VMMA(va, 2); __builtin_amdgcn_sched_barrier(0); \
        VMMA(vb, 3); __builtin_amdgcn_sched_barrier(0); } while (0)
#define QK_SM(t, s) do { \
        const lds_cptr kp = kp0 + (s) * DK_SLOT; bf16x8 kf[8]; \
        _Pragma("unroll") for (int d0 = 0; d0 < 4; ++d0) { kf[2 * d0] = kfrag(kp + d0 * 2048); kf[2 * d0 + 1] = kfrag(kp + d0 * 2048 + 512); } \
        __builtin_amdgcn_sched_barrier(0); \
        f32x16 p0 = MFMA32(kf[0], qr[0], (f32x16){}), p1 = MFMA32(kf[1], qr[0], (f32x16){}); \
        _Pragma("unroll") for (int d0 = 1; d0 < 4; ++d0) { p0 = MFMA32(kf[2 * d0], qr[d0], p0); p1 = MFMA32(kf[2 * d0 + 1], qr[d0], p1); } \
        const int jb = (t) - (NT - 4); \
        if (jb >= 0) { const int kb = 64 * jb + 4 * hi;                        \
            _Pragma("unroll") for (int r = 0; r < 16; ++r) { const int kv = kb + (r & 3) + 8 * (r >> 2); if (kv > qrel) p0[r] = -INFINITY; if (kv + 32 > qrel) p1[r] = -INFINITY; } } \
        const float rm = rowmax2(p0, p1); \
          \
        const float grow = rm - mref; \
        const float dl = ((t) == 0) ? grow : ((grow > (float)THRL) ? grow : 0.f); \
        const float f = ((t) == 0) ? 1.f : __builtin_amdgcn_exp2f(-dl); \
        mref += dl; l_reg *= f; \
        if (__any(f != 1.f)) { _Pragma("unroll") for (int d = 0; d < 4; ++d) _Pragma("unroll") for (int r = 0; r < 16; ++r) o[d][r] *= f; } \
        float s0 = 0.f, s1 = 0.f; \
        _Pragma("unroll") for (int r = 0; r < 16; ++r) { p0[r] = __builtin_amdgcn_exp2f(p0[r] - mref); p1[r] = __builtin_amdgcn_exp2f(p1[r] - mref); s0 = __builtin_fmaf(p0[r], Wr[r], s0); s1 = __builtin_fmaf(p1[r], Wr[r], s1); } \
        l_reg += Whi * (s0 + W32 * s1); \
        pw[0] = (u32x4){PKF(p0, 0), PKF(p0, 2), PKF(p0, 4), PKF(p0, 6)}; pw[1] = (u32x4){PKF(p0, 8), PKF(p0, 10), PKF(p0, 12), PKF(p0, 14)}; \
        pw[2] = (u32x4){PKF(p1, 0), PKF(p1, 2), PKF(p1, 4), PKF(p1, 6)}; pw[3] = (u32x4){PKF(p1, 8), PKF(p1, 10), PKF(p1, 12), PKF(p1, 14)}; \
        mref -= B64;                                                           \
    } while (0)
    int slot = 0, slotp = D_NSLOT - 1, slot2 = 2;
    if (!late) {
#pragma unroll 1
        for (int t = 0; t < NT; ++t) {
            if (t + 1 < NT) WAIT_BAR(3); else WAIT_BAR(0);
            if (t + 2 < NT) DMA_T(t + 2, slot2);
            QK_SM(t, slot);
            PV_STEP(slot);
            slotp = slot; slot = (slot == D_NSLOT - 1) ? 0 : slot + 1; slot2 = (slot2 == D_NSLOT - 1) ? 0 : slot2 + 1;
        }
    } else {
        WAIT_BAR(3); DMA_T(2, slot2);
        QK_SM(0, slot);
        slotp = slot; slot = 1; slot2 = 3;
#pragma unroll 1
        for (int t = 1; t < NT; ++t) {
            if (t + 1 < NT) WAIT_BAR(3); else WAIT_BAR(0);
            if (t + 2 < NT) DMA_T(t + 2, slot2);
            PV_STEP(slotp);
            QK_SM(t, slot);
            slotp = slot; slot = (slot == D_NSLOT - 1) ? 0 : slot + 1; slot2 = (slot2 == D_NSLOT - 1) ? 0 : slot2 + 1;
        }
        PV_STEP(slotp);
    }
    l_out = half_swap_sum(l_reg);
    WAIT_BAR(0);
#undef DMA_T
#undef VLOAD
#undef VMMA
#undef PV_STEP
#undef QK_SM
}

__device__ __forceinline__ void diff_unit(int b, int h, int qb, const bf16* QB, const bf16* KB, const bf16* VB, bf16* MIX, float* stash, float lam, const float* subg, char* shm) {
    int tid_ = threadIdx.x; asm volatile("" : "+v"(tid_));
    const int tid = tid_, lane = tid & 63, r32 = lane & 31, hi = lane >> 5; const int wid = __builtin_amdgcn_readfirstlane(tid >> 6);
    f32x16 o[4]; float l;
#pragma unroll 1
    for (int m = 0; m < 2; ++m) {
        diff_pass<6>(b, h, m, qb, QB, KB, VB, shm, o, l);
        if (m == 0) {
            const float rl = __builtin_amdgcn_rcpf(l);
            f32x4* st = (f32x4*)stash + tid * 16;
#pragma unroll
            for (int d = 0; d < 4; ++d)
#pragma unroll
                for (int g = 0; g < 4; ++g) st[d * 4 + g] = (f32x4){o[d][4 * g] * rl, o[d][4 * g + 1] * rl, o[d][4 * g + 2] * rl, o[d][4 * g + 3] * rl};
        } else {
            const float rl = lam * __builtin_amdgcn_rcpf(l);
            const f32x4* st = (const f32x4*)stash + tid * 16; float ss = 0.f;
#pragma unroll
            for (int d = 0; d < 4; ++d)
#pragma unroll
                for (int g = 0; g < 4; ++g) { const f32x4 a = st[d * 4 + g];
#pragma unroll
                    for (int e = 0; e < 4; ++e) { const float v = a[e] - o[d][4 * g + e] * rl; o[d][4 * g + e] = v; ss = __builtin_fmaf(v, v, ss); } }
            ss = half_swap_sum(ss);
            const float rs = 0.8f * __builtin_amdgcn_rsqf(ss * (1.0f / 128.0f) + 1e-6f);
            bf16* orow = MIX + ((long)b * SEQ + qb * 256 + wid * 32 + r32) * 1024 + 512 + h * 128 + 4 * hi;
#pragma unroll
            for (int d = 0; d < 4; ++d)
#pragma unroll
                for (int g = 0; g < 4; ++g) { const f32x4 gg = *(const f32x4*)(subg + 32 * d + 8 * g + 4 * hi);
                    u32x2 w; w.x = cvtpk(o[d][4 * g] * rs * gg[0], o[d][4 * g + 1] * rs * gg[1]); w.y = cvtpk(o[d][4 * g + 2] * rs * gg[2], o[d][4 * g + 3] * rs * gg[3]);
                    *(u32x2*)(orow + 32 * d + 8 * g) = w; }
        }
    }
}

__device__ __forceinline__ void swa_unit(int b, int nb, const bf16* QA, const bf16* KA, const bf16* VA, bf16* MIX, const float* sinks, const float* gain, char* shm, int ss_off) {
    int tid_ = threadIdx.x; asm volatile("" : "+v"(tid_));
    const int tid = tid_, lane = tid & 63, r32 = lane & 31, hi = lane >> 5; const int wid = __builtin_amdgcn_readfirstlane(tid >> 6);
    const long t0 = (long)b * SEQ + nb * 128;
    LAS char* sh = (LAS char*)shm;
#pragma unroll 4
    for (int i = 0; i < 16; ++i) {
        const int p = i * 512 + tid, kvh = p >> 12, rem = p & 4095, isV = rem >> 11, r2 = rem & 2047, key = r2 >> 3, c = r2 & 7;
        const bool valid = (nb > 0) || key >= 128;
        const bf16* src = (isV ? VA : KA) + (t0 - 128 + key) * 128 + kvh * 64 + c * 8;
        u32x4 v = (u32x4){0u, 0u, 0u, 0u}; if (valid) v = *(const u32x4*)src;
        const int dst = isV ? (65536 + kvh * 32768 + (c >> 2) * 16384 + (key >> 4) * 1024 + (key & 15) * 64 + (c & 3) * 16) : (kvh * 32768 + c * 4096 + key * 16);
        *(LAS u32x4*)(sh + dst) = v;
    }
    __syncthreads();
    const int hq = wid, kvh = wid >> 2;
    const float slope2 = LOG2E * __builtin_amdgcn_exp2f(-0.5f * (float)(hq + 1)), sink2 = sinks[hq] * LOG2E;
    const lds_cptr Kf = (lds_cptr)shm + kvh * 32768 + hi * 4096 + r32 * 16;
    const lds_cptr Vf = (lds_cptr)shm + 65536 + kvh * 32768 + ((lane >> 4) & 1) * 32 + (lane & 3) * 8 + (4 * hi + ((lane & 15) >> 2)) * 64;
    LAS float* SS = (LAS float*)(sh + ss_off);
    for (int i = 0; i < 4; ++i) {
        const bf16* Qw = QA + (t0 + 32 * i + r32) * 512 + hq * 64 + hi * 8;
        bf16x8 qr[4];
#pragma unroll
        for (int d0 = 0; d0 < 4; ++d0) qr[d0] = *reinterpret_cast<const bf16x8*>(Qw + d0 * 16);
        f32x16 s[5];
#pragma unroll
        for (int c5 = 0; c5 < 5; ++c5) {
            const int ch = i + c5; const lds_cptr kp = Kf + ch * 512;
            f32x16 a = f32x16{};
#pragma unroll
            for (int d0 = 0; d0 < 4; ++d0) a = MFMA32(kfrag(kp + d0 * 8192), qr[d0], a);
            const int base = 128 + 32 * i + r32 - 32 * ch - 4 * hi;
#pragma unroll
            for (int r = 0; r < 16; ++r) { const int dist = base - ((r & 3) + 8 * (r >> 2)); const int fk = 32 * ch + 4 * hi + (r & 3) + 8 * (r >> 2);
                const bool ok = dist >= 0 && dist < 128 && (nb > 0 || fk >= 128);
                a[r] = ok ? a[r] - slope2 * (float)dist : -INFINITY; }
            s[c5] = a;
        }
        float mx = sink2;
#pragma unroll
        for (int c5 = 0; c5 < 5; ++c5)
#pragma unroll
            for (int r = 0; r < 16; r += 2) mx = MX3(mx, s[c5][r], s[c5][r + 1]);
        mx = half_swap_max(mx);
        float ls = 0.f;
#pragma unroll
        for (int c5 = 0; c5 < 5; ++c5)
#pragma unroll
            for (int r = 0; r < 16; ++r) { s[c5][r] = __builtin_amdgcn_exp2f(s[c5][r] - mx); ls += s[c5][r]; }
        ls = half_swap_sum(ls) + __builtin_amdgcn_exp2f(sink2 - mx);
        f32x16 o[2]; o[0] = f32x16{}; o[1] = f32x16{};
#pragma unroll
        for (int c5 = 0; c5 < 5; ++c5)
#pragma unroll
            for (int k2 = 0; k2 < 2; ++k2) {
                const u32x4 pw = (u32x4){PKF(s[c5], 8 * k2), PKF(s[c5], 8 * k2 + 2), PKF(s[c5], 8 * k2 + 4), PKF(s[c5], 8 * k2 + 6)};
                const int kg = 2 * (i + c5) + k2;
#pragma unroll
                for (int d0 = 0; d0 < 2; ++d0) {
                    const s16x4 lo = vtr(Vf + d0 * 16384 + kg * 1024), hv = vtr(Vf + d0 * 16384 + kg * 1024 + 512);
                    const bf16x8 vf = (bf16x8){lo[0], lo[1], lo[2], lo[3], hv[0], hv[1], hv[2], hv[3]};
                    o[d0] = MFMA32(vf, __builtin_bit_cast(bf16x8, pw), o[d0]);
                }
            }
        const float rl = __builtin_amdgcn_rcpf(ls); float ss = 0.f;
        bf16* orow = MIX + (t0 + 32 * i + r32) * 1024 + hq * 64 + 4 * hi;
#pragma unroll
        for (int d0 = 0; d0 < 2; ++d0)
#pragma unroll
            for (int g = 0; g < 4; ++g) {
                const float y0 = o[d0][4 * g] * rl, y1 = o[d0][4 * g + 1] * rl, y2 = o[d0][4 * g + 2] * rl, y3 = o[d0][4 * g + 3] * rl;
                ss += (y0 * y0 + y1 * y1) + (y2 * y2 + y3 * y3);
                u32x2 w; w.x = cvtpk(y0, y1); w.y = cvtpk(y2, y3); *(u32x2*)(orow + 32 * d0 + 8 * g) = w; }
        ss = half_swap_sum(ss);
        if (hi == 0) SS[(32 * i + r32) * 8 + hq] = ss;
    }
    __syncthreads();
#pragma unroll 4
    for (int i = 0; i < 16; ++i) {
        const int idx = i * 512 + tid, row = idx >> 6, chn = idx & 63;
        const f32x4 sa = *(const LAS f32x4*)(SS + row * 8), sb = *(const LAS f32x4*)(SS + row * 8 + 4);
        const float tot = (sa[0] + sa[1]) + (sa[2] + sa[3]) + (sb[0] + sb[1]) + (sb[2] + sb[3]);
        const float rr = __builtin_amdgcn_rsqf(tot * (1.0f / 512.0f) + 1e-6f);
        u32x4* pp = (u32x4*)(MIX + (t0 + row) * 1024 + chn * 8); const u32x4 v = *pp;
        const f32x4 g0 = *(const f32x4*)(gain + chn * 8), g1 = *(const f32x4*)(gain + chn * 8 + 4);
        u32x4 w;
        w.x = cvtpk(__uint_as_float(v.x << 16) * rr * g0[0], __uint_as_float(v.x & 0xffff0000u) * rr * g0[1]);
        w.y = cvtpk(__uint_as_float(v.y << 16) * rr * g0[2], __uint_as_float(v.y & 0xffff0000u) * rr * g0[3]);
        w.z = cvtpk(__uint_as_float(v.z << 16) * rr * g1[0], __uint_as_float(v.z & 0xffff0000u) * rr * g1[1]);
        w.w = cvtpk(__uint_as_float(v.w << 16) * rr * g1[2], __uint_as_float(v.w & 0xffff0000u) * rr * g1[3]);
        *pp = w;
    }
    __syncthreads();
}
#undef WAIT_BAR
#undef PKF
#undef MX3
#undef MFMA32
}

constexpr int NWAVES = 8;
constexpr int BATCH = 4, SEQ = 8192, DM = 1024, MTOK = BATCH * SEQ;
constexpr int NPROJ = 2304, DFF = 4096, NUP = 2 * DFF;
constexpr float EPS = 1e-6f, LOG2E_F = 1.4426950408889634f, QSCALE = 0.125f * 1.4426950408889634f;
constexpr size_t MiB = 1u << 20;
constexpr size_t WS_CTL = 0, WS_WIN = 1 * MiB, WS_WOUT = 6 * MiB, WS_WUP = 8 * MiB, WS_WDN = 24 * MiB, WS_XN = 32 * MiB;
constexpr size_t WS_QA = 96 * MiB, WS_KA = 128 * MiB, WS_VA = 136 * MiB, WS_QB = 144 * MiB, WS_KB = 176 * MiB, WS_VB = 208 * MiB, WS_MIX = 240 * MiB, WS_STASH = 304 * MiB;
constexpr size_t WS_ORAW = 96 * MiB, WS_ACT = 96 * MiB, WS_UB = 352 * MiB, WS_FRAW = 384 * MiB, WS_END = 448 * MiB;
constexpr int RING_BYTES = 131072, SS_OFF = RING_BYTES, LDS_BYTES = 147456;

#define GAS __attribute__((address_space(1)))
typedef unsigned short bf16;
typedef unsigned v4u __attribute__((ext_vector_type(4)));
typedef unsigned v2u __attribute__((ext_vector_type(2)));
typedef float f32x4 __attribute__((ext_vector_type(4)));
#define LDS_WAIT() asm volatile("s_waitcnt lgkmcnt(0)" ::: "memory")
__device__ __forceinline__ unsigned f2bf(float f) { unsigned u = __builtin_bit_cast(unsigned, f); return (u + 0x7fffu + ((u >> 16) & 1u)) >> 16; }
__device__ __forceinline__ unsigned pk2(float lo, float hi) { return f2bf(lo) | (f2bf(hi) << 16); }
__device__ __forceinline__ float bflo(unsigned w) { return __uint_as_float(w << 16); }
__device__ __forceinline__ float bfhi(unsigned w) { return __uint_as_float(w & 0xffff0000u); }
__device__ __forceinline__ float wave_sum(float v) {
#pragma unroll
    for (int o = 1; o < 64; o <<= 1) v += __shfl_xor(v, o);
    return v;
}
template <int MODE>
__device__ __forceinline__ void p0_transpose_item(const float* W, int K, int N, bf16* WT, const float* gain, LAS float* scr, int item, int lane) {
    const int nblk = N / 32, kb = item / nblk, nb = item % nblk, k0 = 64 * kb, n0 = 32 * nb;
#pragma unroll 8
    for (int i = 0; i < 32; ++i) { const int kk = 2 * i + (lane >> 5); float w = W[(size_t)(k0 + kk) * N + n0 + (lane & 31)]; if (MODE != 0) w *= gain[k0 + kk]; scr[kk * 33 + (lane & 31)] = w; }
    LDS_WAIT(); asm volatile("" ::: "memory");
    float cs = 1.f; if (MODE == 1) { if (n0 < 512 || (n0 >= 768 && n0 < 1280)) cs = QSCALE; }
    int r0 = n0; if (MODE == 2) { const int f = n0 & 4095; r0 = (f >> 7) * 256 + ((n0 >= 4096) ? 128 : 0) + (f & 127); }
    const int c = lane & 7;
#pragma unroll
    for (int j = 0; j < 4; ++j) { const int n = (lane >> 3) + 8 * j; const LAS float* s = scr + (8 * c) * 33 + n;
        v4u o; o.x = pk2(s[0 * 33] * cs, s[1 * 33] * cs); o.y = pk2(s[2 * 33] * cs, s[3 * 33] * cs); o.z = pk2(s[4 * 33] * cs, s[5 * 33] * cs); o.w = pk2(s[6 * 33] * cs, s[7 * 33] * cs);
        *(GAS v4u*)(WT + (size_t)(r0 + n) * K + k0 + 8 * c) = o; }
    LDS_WAIT(); asm volatile("" ::: "memory");
}
__device__ __forceinline__ void rms_row_to_bf16(const float* xrow, bf16* orow, int lane) {
    const GAS f32x4* xr = (const GAS f32x4*)xrow + lane;
    f32x4 v[4]; float s = 0.f;
#pragma unroll
    for (int j = 0; j < 4; ++j) { v[j] = xr[64 * j]; s += (v[j].x * v[j].x + v[j].y * v[j].y) + (v[j].z * v[j].z + v[j].w * v[j].w); }
    const float r = 1.0f / sqrtf(wave_sum(s) * (1.f / DM) + EPS);
    GAS v2u* o8 = (GAS v2u*)orow + lane;
#pragma unroll
    for (int j = 0; j < 4; ++j) { v2u w; w.x = pk2(v[j].x * r, v[j].y * r); w.y = pk2(v[j].z * r, v[j].w * r); o8[64 * j] = w; }
}
template <bool WITH_XN>
__device__ __forceinline__ void post_row(const bf16* raw, const float* base, const float* g, float* out, bf16* xn, int lane) {
    const GAS v2u* rr = (const GAS v2u*)raw + lane; const GAS f32x4* br = (const GAS f32x4*)base + lane; const GAS f32x4* gr = (const GAS f32x4*)g + lane;
    f32x4 o[4], xb[4]; float s = 0.f;
#pragma unroll
    for (int j = 0; j < 4; ++j) { const v2u w = rr[64 * j]; o[j] = (f32x4){bflo(w.x), bfhi(w.x), bflo(w.y), bfhi(w.y)}; xb[j] = br[64 * j]; s += (o[j].x * o[j].x + o[j].y * o[j].y) + (o[j].z * o[j].z + o[j].w * o[j].w); }
    const float r = 1.0f / sqrtf(wave_sum(s) * (1.f / DM) + EPS);
    float s2 = 0.f; GAS f32x4* orow = (GAS f32x4*)out + lane;
#pragma unroll
    for (int j = 0; j < 4; ++j) { const f32x4 gg = gr[64 * j]; xb[j] = xb[j] + o[j] * r * gg; orow[64 * j] = xb[j]; s2 += (xb[j].x * xb[j].x + xb[j].y * xb[j].y) + (xb[j].z * xb[j].z + xb[j].w * xb[j].w); }
    if (WITH_XN) {
        const float r2 = 1.0f / sqrtf(wave_sum(s2) * (1.f / DM) + EPS);
        GAS v2u* o8 = (GAS v2u*)xn + lane;
#pragma unroll
        for (int j = 0; j < 4; ++j) { v2u w; w.x = pk2(xb[j].x * r2, xb[j].y * r2); w.y = pk2(xb[j].z * r2, xb[j].w * r2); o8[64 * j] = w; }
    }
}

#ifndef PHASE_MASK
#define PHASE_MASK 0x1ff
#endif
#ifndef REPEAT_MASK
#define REPEAT_MASK 0
#endif
#define REP(k) for (int rep_ = 0; rep_ <= ((REPEAT_MASK >> (k)) & 1); ++rep_)
#define PH(k) if ((PHASE_MASK >> (k)) & 1) REP(k)
#define XB_TMO      128
#define XB_XCNT(j)  (256  + 64 * (j))
#define XB_XSUB(j)  (1280 + 64 * (j))
#define XB_XGEN(j)  (2304 + 64 * (j))
#define XB_TOP      3328
#define XB_TOPGEN   3392
#define XCD_BAR_WORDS 3456
#define XB_SPIN_CAP (1u << 18)

__device__ __forceinline__ unsigned xb_ld(unsigned* p)              { return __hip_atomic_load(p, __ATOMIC_RELAXED, __HIP_MEMORY_SCOPE_AGENT); }
__device__ __forceinline__ unsigned xb_add(unsigned* p, unsigned v) { return __hip_atomic_fetch_add(p, v, __ATOMIC_RELAXED, __HIP_MEMORY_SCOPE_AGENT); }
__device__ __forceinline__ unsigned xb_xcc_id() { return (unsigned)__builtin_amdgcn_s_getreg((3 << 11) | 20) & 0xFu; }
#define XB_SPIN(cond, bar) do { unsigned _sp = 0; while (cond) { __builtin_amdgcn_s_sleep(1); \
    if ((++_sp & 255u) == 0u) { if (xb_ld(&(bar)[XB_TMO])) break; if (_sp > XB_SPIN_CAP) { atomicAdd(&(bar)[XB_TMO], 1u); break; } } } } while (0)

struct XcdBarrier {
    unsigned* bar; unsigned x;
    volatile LAS unsigned* st;
};

__device__ __forceinline__ XcdBarrier xcd_barrier_post(unsigned* bar, volatile LAS unsigned* st) {
    XcdBarrier b; b.bar = bar; b.x = xb_xcc_id(); b.st = st;
    if (threadIdx.x == 0) (void)xb_add(&bar[XB_XCNT(b.x)], 1u);
    return b;
}
__device__ __forceinline__ void xcd_barrier_complete(unsigned* bar, unsigned x, unsigned& nloc, unsigned& nx) {
    const unsigned G = gridDim.x * gridDim.y * gridDim.z;
    unsigned sum, cnt, mine, sp = 0u;
    for (;;) {
        sum = 0u; cnt = 0u; mine = 0u;
#pragma unroll
        for (unsigned j = 0; j < 16; ++j) { const unsigned c = xb_ld(&bar[XB_XCNT(j)]); sum += c; cnt += (c > 0u) ? 1u : 0u; mine = (j == x) ? c : mine; }
        if (sum == G) break;
        __builtin_amdgcn_s_sleep(1);
        if ((++sp & 255u) == 0u) { if (xb_ld(&bar[XB_TMO])) break; if (sp > XB_SPIN_CAP) { atomicAdd(&bar[XB_TMO], 1u); break; } }
    }
    nloc = mine > 0u ? mine : 1u; nx = cnt > 0u ? cnt : 1u;
}

__device__ __forceinline__ void xcd_barrier(const XcdBarrier& b) {
    asm volatile("s_waitcnt vmcnt(0)" ::: "memory");
    __syncthreads();
    if (threadIdx.x == 0) {
        unsigned* bar = b.bar;
        __builtin_amdgcn_s_waitcnt(0);
        unsigned nloc = b.st[0], nx = b.st[1];
        if (nloc == 0u) { xcd_barrier_complete(bar, b.x, nloc, nx); b.st[0] = nloc; b.st[1] = nx; }
        const unsigned old = xb_add(&bar[XB_XSUB(b.x)], 1u);
        const unsigned gen = old / nloc;
        if (old + 1u == (gen + 1u) * nloc) {
            __builtin_amdgcn_fence(__ATOMIC_RELEASE, "agent");
            asm volatile("s_waitcnt vmcnt(0)" ::: "memory");
            const unsigned og = xb_add(&bar[XB_TOP], 1u);
            const unsigned tg = og / nx;
            if (og + 1u == (tg + 1u) * nx) xb_add(&bar[XB_TOPGEN], 1u);
            else XB_SPIN(xb_ld(&bar[XB_TOPGEN]) == tg, bar);
            __builtin_amdgcn_fence(__ATOMIC_ACQUIRE, "agent");
            xb_add(&bar[XB_XGEN(b.x)], 1u);
            asm volatile("s_waitcnt vmcnt(0)" ::: "memory");
        } else {
            XB_SPIN(xb_ld(&bar[XB_XGEN(b.x)]) == gen, bar);
            __builtin_amdgcn_fence(__ATOMIC_ACQUIRE, "agent");
            asm volatile("s_waitcnt vmcnt(0)" ::: "memory");
        }
    }
    __syncthreads();
}

constexpr int MISC_OFF = RING_BYTES + 4096;
#define GRID_BAR() do { XcdBarrier b_; b_.bar = (unsigned*)(args.ws + WS_CTL); b_.x = xb_xcc_id(); b_.st = (volatile LAS unsigned*)((LAS unsigned char*)lds + MISC_OFF) + 8; xcd_barrier(b_); } while (0)
#define PHASE_LOCALS \
    int tid = threadIdx.x; asm volatile("" : "+v"(tid)); \
    const int lane = tid & 63, wave = __builtin_amdgcn_readfirstlane(tid >> 6); \
    int G = gridDim.x, bx = blockIdx.x; asm volatile("" : "+s"(G), "+s"(bx)); \
    const int vcu = (G % 8 == 0) ? (bx % 8) * (G / 8) + bx / 8 : bx; \
    unsigned char* ws = args.ws; asm volatile("" : "+s"(ws)); \
    const float* x = args.in[0]; \
    bf16* Wt_in = (bf16*)(ws + WS_WIN); bf16* Wt_out = (bf16*)(ws + WS_WOUT); bf16* Wt_up = (bf16*)(ws + WS_WUP); bf16* Wt_dn = (bf16*)(ws + WS_WDN); \
    bf16* XN = (bf16*)(ws + WS_XN); \
    bf16* QA = (bf16*)(ws + WS_QA); bf16* KA = (bf16*)(ws + WS_KA); bf16* VA = (bf16*)(ws + WS_VA); \
    bf16* QB = (bf16*)(ws + WS_QB); bf16* KB = (bf16*)(ws + WS_KB); bf16* VB = (bf16*)(ws + WS_VB); \
    bf16* MIX = (bf16*)(ws + WS_MIX); float* STASH = (float*)(ws + WS_STASH); \
    bf16* ORAW = (bf16*)(ws + WS_ORAW); bf16* ACT = (bf16*)(ws + WS_ACT); float* UB = (float*)(ws + WS_UB); bf16* FRAW = (bf16*)(ws + WS_FRAW); \
    LAS unsigned char* ldsl = (LAS unsigned char*)lds; \
    const int gw = vcu * NWAVES + wave, NGW = G * NWAVES; \
    (void)lane; (void)x; (void)Wt_in; (void)Wt_out; (void)Wt_up; (void)Wt_dn; (void)XN; (void)QA; (void)KA; (void)VA; (void)QB; (void)KB; (void)VB; (void)MIX; (void)STASH; (void)ORAW; (void)ACT; (void)UB; (void)FRAW; (void)ldsl; (void)gw; (void)NGW;
struct Args { const float* in[18]; float* out; unsigned char* ws; };

__global__ void __launch_bounds__(NWAVES * 64, 2) hymba_fwd(Args args) {
    extern __shared__ __attribute__((aligned(16))) unsigned char lds[];
    { volatile LAS unsigned* misc = (volatile LAS unsigned*)((LAS unsigned char*)lds + MISC_OFF); if (threadIdx.x < 32) misc[threadIdx.x] = 0u; __syncthreads();
      (void)xcd_barrier_post((unsigned*)(args.ws + WS_CTL), misc + 8); }
    PH(0) { PHASE_LOCALS
        LAS float* scr = (LAS float*)(ldsl + wave * 16384);
        constexpr int I_IN = (DM / 64) * (NPROJ / 32), I_OUT = (DM / 64) * (DM / 32), I_UP = (DM / 64) * (NUP / 32), I_DN = (DFF / 64) * (DM / 32);
        constexpr int NITEMS = I_IN + I_OUT + I_UP + I_DN;
        for (int it = gw; it < NITEMS; it += NGW) {
            int r = it;
            if (r < I_IN) { p0_transpose_item<1>(args.in[2], DM, NPROJ, Wt_in, args.in[1], scr, r, lane); continue; } r -= I_IN;
            if (r < I_OUT) { p0_transpose_item<0>(args.in[10], DM, DM, Wt_out, nullptr, scr, r, lane); continue; } r -= I_OUT;
            if (r < I_UP) { p0_transpose_item<2>(args.in[13], DM, NUP, Wt_up, args.in[12], scr, r, lane); continue; } r -= I_UP;
            p0_transpose_item<0>(args.in[16], DFF, DM, Wt_dn, nullptr, scr, r, lane);
        }
        for (int m = gw; m < MTOK; m += NGW) rms_row_to_bf16(x + (size_t)m * DM, XN + (size_t)m * DM, lane);
    }
    GRID_BAR();

    PH(1) { PHASE_LOCALS
        pg8::Gemm g{XN, Wt_in, MTOK, NPROJ, DM}; pg8::StaticOrder S; S.init(MTOK, NPROJ, G, bx);
        pg8::EpiProj E{QA, KA, VA, QB, KB, VB};
        pg8::gemm_phase<pg8::EpiProj, pg8::StaticOrder, true, true>(ldsl, g, S, E);
    }
    GRID_BAR();

    PH(2) { PHASE_LOCALS
        const float d1 = wave_sum(args.in[5][lane] * args.in[6][lane]), d2 = wave_sum(args.in[7][lane] * args.in[8][lane]);
        const float lam = __expf(d1) - __expf(d2) + 0.2f;
#ifndef ATT_NO_SWA
        REP(9) for (int u = vcu; u < BATCH * (SEQ / 128); u += G)
            att::swa_unit(u / (SEQ / 128), u % (SEQ / 128), QA, KA, VA, MIX, args.in[3], args.in[4], (char*)lds, SS_OFF);
#endif
#ifndef ATT_NO_DIFF
        REP(10) for (int v = vcu; v < 256; v += G) {
            const int bh = v >> 4, s = v & 15;
            att::diff_unit(bh >> 2, bh & 3, s, QB, KB, VB, MIX, STASH + (size_t)bx * 32768, lam, args.in[9], (char*)lds);
            att::diff_unit(bh >> 2, bh & 3, 31 - s, QB, KB, VB, MIX, STASH + (size_t)bx * 32768, lam, args.in[9], (char*)lds);
        }
#endif
    }
    GRID_BAR();

    PH(3) { PHASE_LOCALS
        pg8::Gemm g{MIX, Wt_out, MTOK, DM, DM}; pg8::StaticOrder S; S.init(MTOK, DM, G, bx);
        pg8::EpiBf16<0> E{ORAW, DM, nullptr, 0, 0, 1.f};
        pg8::gemm_phase<pg8::EpiBf16<0>, pg8::StaticOrder, true, true>(ldsl, g, S, E);
    }
    GRID_BAR();
    PH(4) { PHASE_LOCALS
        for (int m = gw; m < MTOK; m += NGW) post_row<true>(ORAW + (size_t)m * DM, x + (size_t)m * DM, args.in[11], args.out + (size_t)m * DM, XN + (size_t)m * DM, lane); }
    GRID_BAR();

    PH(5) { PHASE_LOCALS
        pg8::Gemm g{XN, Wt_up, MTOK, NUP, DM}; pg8::StaticOrder S; S.init(MTOK, NUP, G, bx);
        pg8::EpiConv E{ACT, UB, args.in[14], args.in[15]};
        pg8::gemm_phase<pg8::EpiConv, pg8::StaticOrder, true, true, true>(ldsl, g, S, E);
    }
    GRID_BAR();
    PH(6) { PHASE_LOCALS
        const float* cw = args.in[14]; const float* cb = args.in[15];
        for (int it = bx * 512 + tid; it < 256 * 1024; it += G * 512) {
            const int span = it >> 10, f = (it & 1023) * 4;
            if ((span & 63) == 0) continue;
            const float* us = UB + (size_t)(span * 4) * 8192 + f; const float* up = UB + (size_t)((span - 1) * 4) * 8192 + f;
            float a0[4], a1[4];
            f32x4 cg0, cg1, cv0, cv1;
            { const f32x4 w0 = *(const f32x4*)(cw + f), w1 = *(const f32x4*)(cw + 8192 + f), w2 = *(const f32x4*)(cw + 16384 + f), bb = *(const f32x4*)(cb + f);
              const f32x4 u0 = *(const f32x4*)us, u1 = *(const f32x4*)(us + 8192), um2 = *(const f32x4*)(up + 2 * 8192), um1 = *(const f32x4*)(up + 3 * 8192);
              cg0 = bb + w2 * u0 + w1 * um1 + w0 * um2; cg1 = bb + w2 * u1 + w1 * u0 + w0 * um1; }
            { const f32x4 w0 = *(const f32x4*)(cw + 4096 + f), w1 = *(const f32x4*)(cw + 8192 + 4096 + f), w2 = *(const f32x4*)(cw + 16384 + 4096 + f), bb = *(const f32x4*)(cb + 4096 + f);
              const f32x4 u0 = *(const f32x4*)(us + 4096), u1 = *(const f32x4*)(us + 8192 + 4096), um2 = *(const f32x4*)(up + 2 * 8192 + 4096), um1 = *(const f32x4*)(up + 3 * 8192 + 4096);
              cv0 = bb + w2 * u0 + w1 * um1 + w0 * um2; cv1 = bb + w2 * u1 + w1 * u0 + w0 * um1; }
#pragma unroll
            for (int e = 0; e < 4; ++e) { a0[e] = pg8::gelu_tanh_gate(cg0[e]) * cv0[e]; a1[e] = pg8::gelu_tanh_gate(cg1[e]) * cv1[e]; }
            v2u w0; w0.x = pk2(a0[0], a0[1]); w0.y = pk2(a0[2], a0[3]); v2u w1; w1.x = pk2(a1[0], a1[1]); w1.y = pk2(a1[2], a1[3]);
            *(v2u*)(ACT + (size_t)(span * 128) * DFF + f) = w0; *(v2u*)(ACT + (size_t)(span * 128 + 1) * DFF + f) = w1;
        }
    }
    GRID_BAR();

    PH(7) { PHASE_LOCALS
        pg8::Gemm g{ACT, Wt_dn, MTOK, DM, DFF}; pg8::StaticOrder S; S.init(MTOK, DM, G, bx);
        pg8::EpiBf16<0> E{FRAW, DM, nullptr, 0, 0, 1.f};
        pg8::gemm_phase<pg8::EpiBf16<0>, pg8::StaticOrder, true, true>(ldsl, g, S, E);
    }
    GRID_BAR();
    PH(8) { PHASE_LOCALS
        for (int m = gw; m < MTOK; m += NGW) post_row<false>(FRAW + (size_t)m * DM, args.out + (size_t)m * DM, args.in[17], args.out + (size_t)m * DM, nullptr, lane); }
}

extern "C" void kernel_launch(void* const* d_in, const int* in_sizes, int n_in, void* d_out, int out_size, void* d_ws, size_t ws_size, hipStream_t stream) {
    static int grid = 0;
    if (grid == 0) {
        if (n_in != 18 || in_sizes[0] != MTOK * DM || out_size != MTOK * DM || ws_size < WS_END) {
            fprintf(stderr, "kernel_launch: unexpected problem shape (n_in %d, in0 %d, out %d, ws %zu); nothing launched\n", n_in, n_in > 0 ? in_sizes[0] : -1, out_size, ws_size); grid = -1; return; }
        int dev = 0, cus = 0, per_cu = 0;
        if (hipGetDevice(&dev) != hipSuccess || hipDeviceGetAttribute(&cus, hipDeviceAttributeMultiprocessorCount, dev) != hipSuccess) { grid = -1; return; }
        if (hipFuncSetAttribute((const void*)hymba_fwd, hipFuncAttributeMaxDynamicSharedMemorySize, LDS_BYTES) != hipSuccess) { fprintf(stderr, "kernel_launch: hipFuncSetAttribute failed\n"); grid = -1; return; }
        if (hipOccupancyMaxActiveBlocksPerMultiprocessor(&per_cu, (const void*)hymba_fwd, NWAVES * 64, LDS_BYTES) != hipSuccess || per_cu < 1) { fprintf(stderr, "kernel_launch: occupancy query says %d blocks per CU\n", per_cu); per_cu = 1; }
        (void)hipGetLastError();
        grid = cus;
    }
    if (grid < 0) return;
    if (hipMemsetAsync((char*)d_ws + WS_CTL, 0, 65536, stream) != hipSuccess) { fprintf(stderr, "kernel_launch: hipMemsetAsync failed\n"); return; }
    Args a{};
    for (int i = 0; i < 18; ++i) a.in[i] = (const float*)d_in[i];
    a.out = (float*)d_out; a.ws = (unsigned char*)d_ws;
    void* kargs[] = {&a};
    hipError_t e = hipLaunchCooperativeKernel((const void*)hymba_fwd, dim3(grid), dim3(NWAVES * 64), kargs, LDS_BYTES, stream);
    if (e != hipSuccess) fprintf(stderr, "kernel_launch: cooperative launch failed: %s (grid %d)\n", hipGetErrorString(e), grid);
}
```
